# Optimizing an MI355X kernel written in HIP

```python
import jax, jax.numpy as jnp
from jax import lax
import numpy as np

D_MODEL = 1024
BATCH = 2
SEQ = 8192
DEPTH = 1

N_HEADS = 8
HEAD_DIM = 64
ATTN_WIDTH = N_HEADS * HEAD_DIM
CONV_WIDTH = D_MODEL // 2
CONV_K = 3
FFN_CONV_K = 3
D_FF = 2816
Q_BLOCK = 128
N_MOD = 6
RMS_EPS = 1e-6
NEG_INF = -1e30
IN_SPLITS = [CONV_WIDTH, CONV_WIDTH, CONV_WIDTH,
             ATTN_WIDTH, ATTN_WIDTH, ATTN_WIDTH,
             N_HEADS,
             D_MODEL, D_MODEL]
IN_WIDTH = sum(IN_SPLITS)
IN_OFFSETS = list(np.cumsum(IN_SPLITS)[:-1])

kernel_name = "hybrid_shortconv_fox_convffn_adaln"


def rmsnorm(x, g):
    xf = x.astype(jnp.float32)
    inv = lax.rsqrt(jnp.mean(xf * xf, axis=-1, keepdims=True) + RMS_EPS)
    return (xf * inv).astype(x.dtype) * g


def causal_dwconv(u, w):
    K = w.shape[0]
    S = u.shape[1]
    up = jnp.pad(u, ((0, 0), (K - 1, 0), (0, 0)))
    out = up[:, 0:S, :] * w[0]
    for k in range(1, K):
        out = out + up[:, k:k + S, :] * w[k]
    return out


def forgetting_attention(q, k, v, log_f):
    B, S, H, hd = q.shape
    nb = S // Q_BLOCK
    scale = 1.0 / np.sqrt(hd)
    F = jnp.cumsum(log_f, axis=1)
    qb = q.reshape(B, nb, Q_BLOCK, H, hd).transpose(1, 0, 3, 2, 4)
    Fq = F.reshape(B, nb, Q_BLOCK, H).transpose(1, 0, 3, 2)
    kh = k.transpose(0, 2, 1, 3)
    vh = v.transpose(0, 2, 1, 3)
    Fk = F.transpose(0, 2, 1)
    kpos = jnp.arange(S)

    def one_block(args):
        i, qi, Fqi = args
        qpos = i * Q_BLOCK + jnp.arange(Q_BLOCK)
        s = jnp.einsum('bhqd,bhkd->bhqk', qi, kh).astype(jnp.float32) * scale
        s = s + (Fqi[..., None] - Fk[:, :, None, :])
        s = jnp.where(kpos[None, :] <= qpos[:, None], s, NEG_INF)
        p = jax.nn.softmax(s, axis=-1)
        return jnp.einsum('bhqk,bhkd->bhqd', p.astype(vh.dtype), vh)

    o = lax.map(one_block, (jnp.arange(nb), qb, Fq))
    return o.transpose(1, 0, 3, 2, 4).reshape(B, S, H * hd)


def setup_inputs(seed: int = 0) -> dict:
    key = jax.random.key(seed)
    ks = jax.random.split(key, 17)
    L = DEPTH

    def nrm(k, shape, s):
        return jax.random.normal(k, shape, jnp.float32) * s

    return {
        "x": nrm(ks[0], (BATCH, SEQ, D_MODEL), 1.0),
        "c": nrm(ks[1], (BATCH, D_MODEL), 1.0),
        "w_ada": nrm(ks[2], (L, D_MODEL, N_MOD * D_MODEL), 0.5 * D_MODEL ** -0.5),
        "b_ada": nrm(ks[3], (L, N_MOD * D_MODEL), 0.02),
        "norm1_g": 1.0 + nrm(ks[4], (L, D_MODEL), 0.02),
        "w_in": nrm(ks[5], (L, D_MODEL, IN_WIDTH), D_MODEL ** -0.5),
        "b_f": 3.0 + nrm(ks[6], (L, N_HEADS), 0.5),
        "conv_a_w": nrm(ks[7], (L, CONV_K, CONV_WIDTH), CONV_K ** -0.5),
        "q_norm_g": 1.0 + nrm(ks[8], (L, HEAD_DIM), 0.02),
        "k_norm_g": 1.0 + nrm(ks[9], (L, HEAD_DIM), 0.02),
        "w_branch_a": nrm(ks[10], (L, CONV_WIDTH, D_MODEL), CONV_WIDTH ** -0.5),
        "w_branch_b": nrm(ks[11], (L, ATTN_WIDTH, D_MODEL), ATTN_WIDTH ** -0.5),
        "w_out": nrm(ks[12], (L, D_MODEL, D_MODEL), D_MODEL ** -0.5),
        "norm2_g": 1.0 + nrm(ks[13], (L, D_MODEL), 0.02),
        "w_up": nrm(ks[14], (L, D_MODEL, 2 * D_FF), D_MODEL ** -0.5),
        "conv_ffn_w": nrm(ks[15], (L, FFN_CONV_K, 2 * D_FF), FFN_CONV_K ** -0.5),
        "w_down": nrm(ks[16], (L, D_FF, D_MODEL), D_FF ** -0.5),
    }


def reference(x, c, w_ada, b_ada, norm1_g, w_in, b_f, conv_a_w, q_norm_g, k_norm_g,
              w_branch_a, w_branch_b, w_out, norm2_g, w_up, conv_ffn_w, w_down):
    B, S, _ = x.shape
    for l in range(DEPTH):
        mod = jnp.einsum('bd,de->be', jax.nn.silu(c), w_ada[l]) + b_ada[l]
        sh1, sc1, g1, sh2, sc2, g2 = jnp.split(mod, N_MOD, axis=-1)

        h = rmsnorm(x, norm1_g[l]) * (1.0 + sc1[:, None, :]) + sh1[:, None, :]
        proj = jnp.einsum('bsd,de->bse', h, w_in[l])
        cb, cc, cv, q, k, v, f_logit, ga, gb = jnp.split(proj, IN_OFFSETS, axis=-1)

        ya = cb * causal_dwconv(cc * cv, conv_a_w[l])

        q = rmsnorm(q.reshape(B, S, N_HEADS, HEAD_DIM), q_norm_g[l])
        k = rmsnorm(k.reshape(B, S, N_HEADS, HEAD_DIM), k_norm_g[l])
        v = v.reshape(B, S, N_HEADS, HEAD_DIM)
        log_f = jax.nn.log_sigmoid((f_logit + b_f[l]).astype(jnp.float32))
        yb = forgetting_attention(q, k, v, log_f)

        ya = jnp.einsum('bsc,cd->bsd', ya, w_branch_a[l])
        yb = jnp.einsum('bsc,cd->bsd', yb, w_branch_b[l])
        merged = jax.nn.sigmoid(ga) * ya + jax.nn.sigmoid(gb) * yb
        mix = jnp.einsum('bsd,de->bse', merged, w_out[l])
        x = x + g1[:, None, :] * mix

        h2 = rmsnorm(x, norm2_g[l]) * (1.0 + sc2[:, None, :]) + sh2[:, None, :]
        u = jnp.einsum('bsd,df->bsf', h2, w_up[l])
        u = causal_dwconv(u, conv_ffn_w[l])
        gate, val = jnp.split(u, 2, axis=-1)
        ff = jnp.einsum('bsf,fd->bsd', jax.nn.silu(gate) * val, w_down[l])
        x = x + g2[:, None, :] * ff
    return x
```

```cpp
#include <hip/hip_runtime.h>
#include <cstdio>
#include <cstdint>
#include <hip/hip_cooperative_groups.h>
namespace pg8 {
#define PG8_LAS __attribute__((address_space(3)))
typedef unsigned short bf16_t;
typedef short bf16x8 __attribute__((ext_vector_type(8)));
typedef float f32x4 __attribute__((ext_vector_type(4)));
typedef unsigned u32x4 __attribute__((ext_vector_type(4)));
constexpr int BM = 256, BK = 64, HALF = 128, HTB = HALF * BK * 2  , STAGE_BYTES = 8 * HTB, NXCD = 8, WGM = 8;

__host__ __device__ __forceinline__ int lds_byte(int r, int c) { const int st = (r >> 4) * 2 + (c >> 5), rr = r & 15, cc = c & 31, ob = rr * 64 + cc * 2; return st * 1024 + (ob ^ (((ob >> 9) & 1) << 5)); }
__host__ __device__ __forceinline__ void stage_rc(int b, int& R, int& C) { const int st = b / 1024, sb = b % 1024, swz = sb ^ (((sb >> 9) & 1) << 5); R = (st >> 1) * 16 + swz / 64; C = (st & 1) * 32 + (swz % 64) / 2; }
__host__ __device__ __forceinline__ int perm32(int rho) { const int n = rho >> 4, i = rho & 15; return 8 * (i >> 2) + 4 * n + (i & 3); }

template <class E, class = void> struct epi_wants_sched { static constexpr bool value = false; };
template <class E> struct epi_wants_sched<E, decltype((void)E::SCHED)> { static constexpr bool value = true; };
struct Unit { int pm, pn; };
struct Gemm { const bf16_t* A; const bf16_t* Bt; int M, N, K; };

struct StaticOrder {
    int nM, nN, nwg, G, c;
    __host__ __device__ void init(int M, int N, int G_, int c_) { nM = M / BM; nN = N / BM; nwg = nM * nN; G = G_; c = c_; }
    __host__ __device__ bool next(int i, Unit& u) const {
        const long L = (long)i * G + c; if (L >= nwg) return false;
        int wgid = (int)L; { const int q = nwg / NXCD, r = nwg % NXCD, xcd = wgid % NXCD, off = wgid / NXCD; wgid = (xcd < r ? xcd * (q + 1) : r * (q + 1) + (xcd - r) * q) + off; }
        const int nig = WGM * nN, gid = wgid / nig, fm = gid * WGM, gsz = (nM - fm) < WGM ? (nM - fm) : WGM;
        u.pm = fm + ((wgid % nig) % gsz); u.pn = (wgid % nig) / gsz; return true;
    }
    __device__ __forceinline__ void a_ready(const Unit&) const {}
    __device__ __forceinline__ void done(const Unit&) const {}
    __host__ __device__ __forceinline__ int arow(const Unit& u) const { return u.pm * BM; }
};
struct HaloOrder : StaticOrder {
    static constexpr int SEQR = 8192, NT_ = 33;
    __host__ __device__ void init(int nseq, int N, int G_, int c_) { nM = nseq * NT_; nN = N / BM; nwg = nM * nN; G = G_; c = c_; }
    __host__ __device__ __forceinline__ int arow(const Unit& u) const { const int b = u.pm / NT_, j = u.pm % NT_; const int st = 254 * j; return b * SEQR + (st < SEQR - 256 ? st : SEQR - 256); }
    __host__ __device__ __forceinline__ int rlo(const Unit& u) const { const int j = u.pm % NT_; return j == 0 ? 0 : (j < NT_ - 1 ? 2 : (254 * (NT_ - 2) + 256) - (SEQR - 256)); }
};

__device__ __forceinline__ unsigned cvt_pk_bf16(float lo, float hi) { unsigned r; asm volatile("v_cvt_pk_bf16_f32 %0, %1, %2" : "=v"(r) : "v"(lo), "v"(hi)); return r; }
typedef float f32x2 __attribute__((ext_vector_type(2)));
__device__ __forceinline__ f32x2 gelu_pk(f32x2 v) {
    const f32x2 av = __builtin_elementwise_abs(v), d = av * 0.2316418882f + 1.0f;
    f32x2 t; t.x = __builtin_amdgcn_rcpf(d.x); t.y = __builtin_amdgcn_rcpf(d.y);
    f32x2 q = t * 0.5307027145f + (-0.7265760135f); q = q * t + 0.7107068705f; q = q * t + (-0.142248368f); q = q * t + 0.127414796f; q = q * t;
    const f32x2 s = (v * v) * (-0.72134752044f);
    f32x2 e; e.x = __builtin_amdgcn_exp2f(s.x); e.y = __builtin_amdgcn_exp2f(s.y);
    const f32x2 m = v * (q * e), r = v - m;
    f32x2 o; o.x = v.x < 0.f ? m.x : r.x; o.y = v.y < 0.f ? m.y : r.y; return o;
}

template <int ACT  > struct EpiBf16 {
    static constexpr bool PERM = true, AFTER_DRAIN = false, MID = false; static_assert(ACT == 0 || ACT == 1, "EpiBf16: ACT is 0 (none) or 1 (gelu_pk)");
    bf16_t* O; int ldc; const float* bias; int split_cols; size_t split_stride; float scale0;
    __device__ __forceinline__ void operator()(const f32x4 (&acc)[2][2][4][2], const Unit& u, int wr, int wc, int fr, int fq) const {
        const int row0 = u.pm * BM + wr * 64 + fr; int colt = u.pn * BM; bf16_t* base = O;
        float sc = 1.f; if (split_cols) { const int t = colt / split_cols; base += (size_t)t * split_stride; colt -= t * split_cols; if (t == 0) sc = scale0; }
        const int col0 = colt + wc * 32 + 8 * fq, bcol0 = u.pn * BM + wc * 32 + 8 * fq;
        f32x4 bv[2][2];
#pragma unroll
        for (int bj = 0; bj < 2; ++bj)
#pragma unroll
            for (int n = 0; n < 2; ++n) bv[bj][n] = bias ? *(const f32x4*)(bias + bcol0 + bj * HALF + 4 * n) : (f32x4){0.f, 0.f, 0.f, 0.f};
#pragma unroll
        for (int ai = 0; ai < 2; ++ai)
#pragma unroll
            for (int m = 0; m < 4; ++m) { bf16_t* rowp = base + (size_t)(row0 + ai * HALF + m * 16) * ldc + col0;
#pragma unroll
                for (int bj = 0; bj < 2; ++bj) { f32x4 v0 = acc[ai][bj][m][0] + bv[bj][0], v1 = acc[ai][bj][m][1] + bv[bj][1];
                    if (ACT == 1) { f32x2 a = gelu_pk((f32x2){v0[0], v0[1]}), b = gelu_pk((f32x2){v0[2], v0[3]}), c = gelu_pk((f32x2){v1[0], v1[1]}), d = gelu_pk((f32x2){v1[2], v1[3]});
                        v0 = (f32x4){a.x, a.y, b.x, b.y}; v1 = (f32x4){c.x, c.y, d.x, d.y}; }
                    v0 = v0 * sc; v1 = v1 * sc; u32x4 w; w.x = cvt_pk_bf16(v0[0], v0[1]); w.y = cvt_pk_bf16(v0[2], v0[3]); w.z = cvt_pk_bf16(v1[0], v1[1]); w.w = cvt_pk_bf16(v1[2], v1[3]);
                    *(u32x4*)(rowp + bj * HALF) = w; } }
    }
};
__device__ __forceinline__ float bf_lo(unsigned w) { return __uint_as_float(w << 16); }
__device__ __forceinline__ float bf_hi(unsigned w) { return __uint_as_float(w & 0xffff0000u); }
__device__ __forceinline__ float sigmoidf_(float x) { return __builtin_amdgcn_rcpf(1.0f + __expf(-x)); }
struct EpiIn {
    static constexpr bool PERM = true, AFTER_DRAIN = false, MID = false;
    bf16_t* CB; size_t st16, offGA, st32; const float* qg; long kdelta; float c2, eps;
    __device__ __forceinline__ void operator()(const f32x4 (&acc)[2][2][4][2], const Unit& u, int wr, int wc, int fr, int fq) const {
        const int pn = u.pn, row0 = u.pm * BM + wr * 64 + fr;
        if (pn >= 6 && pn < 10) {
            const bool isq = pn < 8; bf16_t* base = CB + (size_t)(pn >> 1) * st16; const float* g = qg + (isq ? 0L : kdelta); const float sc = isq ? c2 : 1.f;
            const int hcol = ((pn & 1) * 4 + wc) * 64;
            f32x4 gv[2][2];
#pragma unroll
            for (int bj = 0; bj < 2; ++bj)
#pragma unroll
                for (int n = 0; n < 2; ++n) gv[bj][n] = *(const f32x4*)(g + 32 * bj + 8 * fq + 4 * n);
#pragma unroll
            for (int ai = 0; ai < 2; ++ai)
#pragma unroll
                for (int m = 0; m < 4; ++m) {
                    float ss = 0.f;
#pragma unroll
                    for (int bj = 0; bj < 2; ++bj)
#pragma unroll
                        for (int n = 0; n < 2; ++n) { const f32x4 x = acc[ai][bj][m][n]; ss += (x[0] * x[0] + x[1] * x[1]) + (x[2] * x[2] + x[3] * x[3]); }
                    ss += __shfl_xor(ss, 16); ss += __shfl_xor(ss, 32);
                    const float inv = __builtin_amdgcn_rsqf(ss * (1.0f / 64.0f) + eps) * sc;
                    bf16_t* rowp = base + (size_t)(row0 + ai * HALF + m * 16) * 512 + hcol + 8 * fq;
#pragma unroll
                    for (int bj = 0; bj < 2; ++bj) { const f32x4 v0 = acc[ai][bj][m][0] * inv * gv[bj][0], v1 = acc[ai][bj][m][1] * inv * gv[bj][1];
                        u32x4 w; w.x = cvt_pk_bf16(v0[0], v0[1]); w.y = cvt_pk_bf16(v0[2], v0[3]); w.z = cvt_pk_bf16(v1[0], v1[1]); w.w = cvt_pk_bf16(v1[2], v1[3]);
                        *(u32x4*)(rowp + 32 * bj) = w; }
                }
        } else {
            if (pn >= 12) {
                bf16_t* rb = CB + offGA; bf16_t* sb = rb + st32; const int colg = (pn - 12) * HALF + wc * 32 + 8 * fq;
#pragma unroll
                for (int ai = 0; ai < 2; ++ai)
#pragma unroll
                    for (int m = 0; m < 4; ++m) { const size_t off = (size_t)(row0 + ai * HALF + m * 16) * 1024 + colg; f32x4 rr[2], sg[2];
#pragma unroll
                        for (int n = 0; n < 2; ++n)
#pragma unroll
                            for (int i = 0; i < 4; ++i) { const float ea = __expf(-acc[ai][0][m][n][i]), eb = __expf(-acc[ai][1][m][n][i]); const float sgb = __builtin_amdgcn_rcpf(1.0f + eb);
                                sg[n][i] = sgb; rr[n][i] = (1.0f + eb) * __builtin_amdgcn_rcpf(1.0f + ea); }
                        u32x4 w; w.x = cvt_pk_bf16(rr[0][0], rr[0][1]); w.y = cvt_pk_bf16(rr[0][2], rr[0][3]); w.z = cvt_pk_bf16(rr[1][0], rr[1][1]); w.w = cvt_pk_bf16(rr[1][2], rr[1][3]);
                        *(u32x4*)(rb + off) = w;
                        w.x = cvt_pk_bf16(sg[0][0], sg[0][1]); w.y = cvt_pk_bf16(sg[0][2], sg[0][3]); w.z = cvt_pk_bf16(sg[1][0], sg[1][1]); w.w = cvt_pk_bf16(sg[1][2], sg[1][3]);
                        *(u32x4*)(sb + off) = w; }
                return;
            }
            bf16_t* base; int ldc, colt; const bool sig = false;
            { base = CB + (size_t)(pn >> 1) * st16; ldc = 512; colt = (pn & 1) * 256; }
            const int col0 = colt + wc * 32 + 8 * fq;
#pragma unroll
            for (int ai = 0; ai < 2; ++ai)
#pragma unroll
                for (int m = 0; m < 4; ++m) { bf16_t* rowp = base + (size_t)(row0 + ai * HALF + m * 16) * ldc + col0;
#pragma unroll
                    for (int bj = 0; bj < 2; ++bj) { f32x4 v0 = acc[ai][bj][m][0], v1 = acc[ai][bj][m][1];
                        if (sig) { v0 = (f32x4){sigmoidf_(v0[0]), sigmoidf_(v0[1]), sigmoidf_(v0[2]), sigmoidf_(v0[3])}; v1 = (f32x4){sigmoidf_(v1[0]), sigmoidf_(v1[1]), sigmoidf_(v1[2]), sigmoidf_(v1[3])}; }
                        u32x4 w; w.x = cvt_pk_bf16(v0[0], v0[1]); w.y = cvt_pk_bf16(v0[2], v0[3]); w.z = cvt_pk_bf16(v1[0], v1[1]); w.w = cvt_pk_bf16(v1[2], v1[3]);
                        *(u32x4*)(rowp + bj * HALF) = w; } }
        }
    }
};
struct EpiMerged {
    static constexpr bool PERM = true, AFTER_DRAIN = false, MID = true;
    const bf16_t *GA, *GB; bf16_t* O;
    __device__ __forceinline__ void mid(f32x4 (&acc)[2][2][4][2], const Unit& u, int wr, int wc, int fr, int fq) const {
        int row0 = u.pm * BM + wr * 64 + fr, col0 = u.pn * BM + wc * 32 + 8 * fq;
        asm volatile("" : "+v"(row0), "+v"(col0));
#pragma unroll
        for (int ai = 0; ai < 2; ++ai)
#pragma unroll
            for (int m = 0; m < 4; ++m) { const size_t off = (size_t)(row0 + ai * HALF + m * 16) * 1024 + col0;
#pragma unroll
                for (int bj = 0; bj < 2; ++bj) { const u32x4 a = __builtin_nontemporal_load((const u32x4*)(GA + off + bj * HALF));
                    acc[ai][bj][m][0] *= (f32x4){bf_lo(a.x), bf_hi(a.x), bf_lo(a.y), bf_hi(a.y)}; acc[ai][bj][m][1] *= (f32x4){bf_lo(a.z), bf_hi(a.z), bf_lo(a.w), bf_hi(a.w)}; asm volatile("" ::: "memory"); } }
    }
    __device__ __forceinline__ void operator()(const f32x4 (&acc)[2][2][4][2], const Unit& u, int wr, int wc, int fr, int fq) const {
        const int row0 = u.pm * BM + wr * 64 + fr, col0 = u.pn * BM + wc * 32 + 8 * fq;
#pragma unroll
        for (int ai = 0; ai < 2; ++ai)
#pragma unroll
            for (int m = 0; m < 4; ++m) { const size_t off = (size_t)(row0 + ai * HALF + m * 16) * 1024 + col0;
#pragma unroll
                for (int bj = 0; bj < 2; ++bj) { const u32x4 b = *(const u32x4*)(GB + off + bj * HALF);
                    const f32x4 v0 = acc[ai][bj][m][0] * (f32x4){bf_lo(b.x), bf_hi(b.x), bf_lo(b.y), bf_hi(b.y)}, v1 = acc[ai][bj][m][1] * (f32x4){bf_lo(b.z), bf_hi(b.z), bf_lo(b.w), bf_hi(b.w)};
                    u32x4 w; w.x = cvt_pk_bf16(v0[0], v0[1]); w.y = cvt_pk_bf16(v0[2], v0[3]); w.z = cvt_pk_bf16(v1[0], v1[1]); w.w = cvt_pk_bf16(v1[2], v1[3]);
                    *(u32x4*)(O + off + bj * HALF) = w; asm volatile("" ::: "memory"); } }
    }
};
template <bool NORM> struct EpiRes {
    static constexpr bool PERM = true, AFTER_DRAIN = false, MID = false;
    const float* base; float* out; const float* gacc; const float* gbias; int rows_per_batch, gstride;
    bf16_t* xn; const float* ng; const float* scacc; const float* scbias; float* ssq; bf16_t* x1b;
    __device__ __forceinline__ void operator()(const f32x4 (&acc)[2][2][4][2], const Unit& u, int wr, int wc, int fr, int fq) const {
        const int b = (u.pm * BM) / rows_per_batch, row0 = u.pm * BM + wr * 64 + fr, col0 = u.pn * BM + wc * 32 + 8 * fq;
        f32x4 gv[2][2], av[2][2];
#pragma unroll
        for (int bj = 0; bj < 2; ++bj)
#pragma unroll
            for (int n = 0; n < 2; ++n) { const int c = col0 + bj * HALF + n * 4;
                gv[bj][n] = *(const f32x4*)(gacc + (size_t)b * gstride + c) + *(const f32x4*)(gbias + c);
                if (NORM) av[bj][n] = *(const f32x4*)(ng + c) * (*(const f32x4*)(scacc + (size_t)b * gstride + c) + *(const f32x4*)(scbias + c) + 1.0f); }
#pragma unroll
        for (int ai = 0; ai < 2; ++ai)
#pragma unroll
            for (int m = 0; m < 4; ++m) { const int row = row0 + ai * HALF + m * 16; const size_t off = (size_t)row * 1024 + col0; float ss = 0.f;
#pragma unroll
                for (int bj = 0; bj < 2; ++bj) { f32x4 o[2];
                    if constexpr (NORM) {
#pragma unroll
                        for (int n = 0; n < 2; ++n) { const f32x4 bs = __builtin_nontemporal_load((const f32x4*)(base + off + bj * HALF + n * 4)); o[n] = bs + gv[bj][n] * acc[ai][bj][m][n]; }
                        u32x4 xw; xw.x = cvt_pk_bf16(o[0][0], o[0][1]); xw.y = cvt_pk_bf16(o[0][2], o[0][3]); xw.z = cvt_pk_bf16(o[1][0], o[1][1]); xw.w = cvt_pk_bf16(o[1][2], o[1][3]);
                        *(u32x4*)(x1b + off + bj * HALF) = xw;
                    } else {
                        const u32x4 xb = __builtin_nontemporal_load((const u32x4*)(x1b + off + bj * HALF));
                        o[0] = (f32x4){bf_lo(xb.x), bf_hi(xb.x), bf_lo(xb.y), bf_hi(xb.y)} + gv[bj][0] * acc[ai][bj][m][0]; o[1] = (f32x4){bf_lo(xb.z), bf_hi(xb.z), bf_lo(xb.w), bf_hi(xb.w)} + gv[bj][1] * acc[ai][bj][m][1];
#pragma unroll
                        for (int n = 0; n < 2; ++n) __builtin_nontemporal_store(o[n], (f32x4*)(out + off + bj * HALF + n * 4));
                    }
                    if (NORM) { ss += (o[0][0] * o[0][0] + o[0][1] * o[0][1]) + (o[0][2] * o[0][2] + o[0][3] * o[0][3]) + (o[1][0] * o[1][0] + o[1][1] * o[1][1]) + (o[1][2] * o[1][2] + o[1][3] * o[1][3]);
                        const f32x4 h0 = o[0] * av[bj][0], h1 = o[1] * av[bj][1];
                        u32x4 w; w.x = cvt_pk_bf16(h0[0], h0[1]); w.y = cvt_pk_bf16(h0[2], h0[3]); w.z = cvt_pk_bf16(h1[0], h1[1]); w.w = cvt_pk_bf16(h1[2], h1[3]);
                        *(u32x4*)(xn + off + bj * HALF) = w; } }
                if (NORM) { ss += __shfl_xor(ss, 16); ss += __shfl_xor(ss, 32); if (fq == 0) atomicAdd(ssq + row, ss); }
                if (m & 1) asm volatile("" ::: "memory"); }
    }
};
__device__ __forceinline__ float dpp_ror1(float x) { return __builtin_bit_cast(float, __builtin_amdgcn_update_dpp(0, __builtin_bit_cast(int, x), 0x121, 0xf, 0xf, false)); }
__device__ __forceinline__ float dpp_ror2(float x) { return __builtin_bit_cast(float, __builtin_amdgcn_update_dpp(0, __builtin_bit_cast(int, x), 0x122, 0xf, 0xf, false)); }
struct EpiUpConv {
    static constexpr bool PERM = true, AFTER_DRAIN = false, MID = false, SCHED = true;
    bf16_t* ACT; const float* ssq; const float* cvec; const float* cw; PG8_LAS float* ex; float invk, eps; int dff, nup, rows_per_batch;
    template <class Sched> __device__ __forceinline__ void run(f32x4 (&acc)[2][2][4][2], const Unit& u, const Sched& S, int wr, int wc, int fr, int fq) const {
        const int arow = S.arow(u), rlo = S.rlo(u), b = arow / rows_per_batch, wid = wr * 4 + wc;
        const int slot0 = u.pn * BM + wc * 32 + 8 * fq, ch0 = u.pn * HALF + wc * 32 + 8 * fq;
        { f32x4 cv[2][2];
#pragma unroll
          for (int bj = 0; bj < 2; ++bj)
#pragma unroll
              for (int n = 0; n < 2; ++n) cv[bj][n] = *(const f32x4*)(cvec + (size_t)b * nup + slot0 + bj * HALF + n * 4);
#pragma unroll
          for (int ai = 0; ai < 2; ++ai)
#pragma unroll
              for (int m = 0; m < 4; ++m) { const float inv = __builtin_amdgcn_rsqf(ssq[arow + ai * HALF + wr * 64 + m * 16 + fr] * invk + eps);
#pragma unroll
                  for (int bj = 0; bj < 2; ++bj)
#pragma unroll
                      for (int n = 0; n < 2; ++n) acc[ai][bj][m][n] = acc[ai][bj][m][n] * inv + cv[bj][n]; } }
        if (fr >= 14) {
#pragma unroll
            for (int ai = 0; ai < 2; ++ai) { PG8_LAS f32x4* d = (PG8_LAS f32x4*)(ex + ((((wid * 2 + ai) * 2 + (fr - 14)) * 4 + fq) * 16));
                d[0] = acc[ai][0][3][0]; d[1] = acc[ai][0][3][1]; d[2] = acc[ai][1][3][0]; d[3] = acc[ai][1][3][1]; }
        }
        asm volatile("s_waitcnt lgkmcnt(0)" ::: "memory"); __builtin_amdgcn_s_barrier(); asm volatile("" ::: "memory");
        typedef unsigned u32x2 __attribute__((ext_vector_type(2)));
#pragma unroll
        for (int n = 0; n < 2; ++n) {
            f32x4 w[3][2];
#pragma unroll
            for (int k = 0; k < 3; ++k)
#pragma unroll
                for (int bj = 0; bj < 2; ++bj) w[k][bj] = *(const f32x4*)(cw + (size_t)k * nup + bj * dff + ch0 + n * 4);
#pragma unroll
            for (int ai = 0; ai < 2; ++ai) {
                f32x4 p1[2], p2[2];
                if (wr == 1 || ai == 1) { const int sw = wr == 1 ? wid - 4 : wid + 4, sa = wr == 1 ? ai : 0;
                    const PG8_LAS f32x4* e1 = (const PG8_LAS f32x4*)(ex + ((((sw * 2 + sa) * 2 + 1) * 4 + fq) * 16)); const PG8_LAS f32x4* e2 = (const PG8_LAS f32x4*)(ex + ((((sw * 2 + sa) * 2 + 0) * 4 + fq) * 16));
#pragma unroll
                    for (int bj = 0; bj < 2; ++bj) { const f32x4 r1 = e1[bj * 2 + n], r2 = e2[bj * 2 + n]; p1[bj] = r1; p2[bj] = fr == 0 ? r2 : r1; }
                } else {
#pragma unroll
                    for (int bj = 0; bj < 2; ++bj) { p1[bj] = (f32x4){0.f, 0.f, 0.f, 0.f}; p2[bj] = (f32x4){0.f, 0.f, 0.f, 0.f}; }
                }
#pragma unroll
                for (int m = 0; m < 4; ++m) {
                    f32x4 cvv[2];
#pragma unroll
                    for (int bj = 0; bj < 2; ++bj) { const f32x4 x = acc[ai][bj][m][n]; f32x4 t1, t2, q1, q2;
#pragma unroll
                        for (int i = 0; i < 4; ++i) { t1[i] = dpp_ror1(x[i]); t2[i] = dpp_ror2(x[i]); q1[i] = fr >= 1 ? t1[i] : p1[bj][i]; q2[i] = fr >= 2 ? t2[i] : p2[bj][i]; }
                        cvv[bj] = w[0][bj] * q2 + w[1][bj] * q1 + w[2][bj] * x;
                        p1[bj] = t1; p2[bj] = t2; }
                    const int lr = ai * HALF + wr * 64 + m * 16 + fr;
                    f32x4 o;
#pragma unroll
                    for (int i = 0; i < 4; ++i) { const float g0 = cvv[0][i]; o[i] = g0 * __builtin_amdgcn_rcpf(1.0f + __expf(-g0)) * cvv[1][i]; }
                    if (lr >= rlo) { u32x2 wv; wv.x = cvt_pk_bf16(o[0], o[1]); wv.y = cvt_pk_bf16(o[2], o[3]); *(u32x2*)(ACT + (size_t)(arow + lr) * dff + ch0 + n * 4) = wv; }
                }
            }
        }
    }
};
struct EpiUp {
    static constexpr bool PERM = true, AFTER_DRAIN = false, MID = false;
    bf16_t* O; int ldc; const float* ssq; const float* cvec; float invk, eps;
    __device__ __forceinline__ void operator()(const f32x4 (&acc)[2][2][4][2], const Unit& u, int wr, int wc, int fr, int fq) const {
        const int row0 = u.pm * BM + wr * 64 + fr, col0 = u.pn * BM + wc * 32 + 8 * fq;
        f32x4 cv[2][2];
#pragma unroll
        for (int bj = 0; bj < 2; ++bj)
#pragma unroll
            for (int n = 0; n < 2; ++n) cv[bj][n] = *(const f32x4*)(cvec + col0 + bj * HALF + n * 4);
#pragma unroll
        for (int ai = 0; ai < 2; ++ai)
#pragma unroll
            for (int m = 0; m < 4; ++m) { const int row = row0 + ai * HALF + m * 16; const float inv = __builtin_amdgcn_rsqf(ssq[row] * invk + eps);
                bf16_t* rowp = O + (size_t)row * ldc + col0;
#pragma unroll
                for (int bj = 0; bj < 2; ++bj) { const f32x4 v0 = acc[ai][bj][m][0] * inv + cv[bj][0], v1 = acc[ai][bj][m][1] * inv + cv[bj][1];
                    u32x4 w; w.x = cvt_pk_bf16(v0[0], v0[1]); w.y = cvt_pk_bf16(v0[2], v0[3]); w.z = cvt_pk_bf16(v1[0], v1[1]); w.w = cvt_pk_bf16(v1[2], v1[3]);
                    *(u32x4*)(rowp + bj * HALF) = w; } }
    }
};
template <class Epi, class Sched, bool ALIGN_EPI = false, bool SP2 = false>
__device__ __forceinline__ void gemm_phase(PG8_LAS unsigned char* lds, const Gemm g, const Sched& S, const Epi& E) {
    const int tid = threadIdx.x, wid = __builtin_amdgcn_readfirstlane(tid >> 6), lane = tid & 63, wr = wid >> 2, wc = wid & 3, fr = lane & 15, fq = lane >> 4;
    const int K = g.K, nt = K / BK;
    unsigned voffA[2], voffB[2];
#pragma unroll
    for (int i = 0; i < 2; ++i) { int R, C; stage_rc(tid * 16 + i * 8192, R, C); const int Rb = Epi::PERM ? ((R & ~31) + perm32(R & 31)) : R;
        voffA[i] = (unsigned)(R * K + C) * 2u; voffB[i] = (unsigned)(Rb * K + C) * 2u; }
    const size_t kstep = (size_t)(BK * 2);
    const size_t hstep = (size_t)HALF * K * 2;
    const size_t tstep = 2 * hstep;
    const unsigned ldsw = (unsigned)wid * 1024u;
    const int aoff = lds_byte(wr * 64 + fr, fq * 8), boff = lds_byte(wc * 32 + fr, fq * 8);
#define PG8_SA(b, h) (((b) * 2 + (h)) * HTB)
#define PG8_SB(b, h) ((4 + (b) * 2 + (h)) * HTB)
#define PG8_STAGE(bufoff, gbase, voff) do { _Pragma("unroll") for (int _i = 0; _i < 2; ++_i) \
        __builtin_amdgcn_global_load_lds((const unsigned*)((const char*)(gbase) + (voff)[_i]), (PG8_LAS unsigned*)(lds + (bufoff) + ldsw + _i * 8192), 16, 0, 0); } while (0)
#define PG8_LDA(dst, b, h) do { _Pragma("unroll") for (int m = 0; m < 4; ++m) _Pragma("unroll") for (int k = 0; k < 2; ++k) dst[m][k] = *(const PG8_LAS bf16x8*)(lds + PG8_SA(b, h) + aoff + m * 2048 + k * 1024); } while (0)
#define PG8_LDB(dst, b, h) do { _Pragma("unroll") for (int n = 0; n < 2; ++n) _Pragma("unroll") for (int k = 0; k < 2; ++k) dst[n][k] = *(const PG8_LAS bf16x8*)(lds + PG8_SB(b, h) + boff + n * 2048 + k * 1024); } while (0)
#define PG8_MMA(ai, bj, At, Bt) do { __builtin_amdgcn_s_setprio(1); _Pragma("unroll") for (int m = 0; m < 4; ++m) _Pragma("unroll") for (int n = 0; n < 2; ++n) _Pragma("unroll") for (int k = 0; k < 2; ++k) \
        acc[ai][bj][m][n] = __builtin_amdgcn_mfma_f32_16x16x32_bf16(Bt[n][k], At[m][k], acc[ai][bj][m][n], 0, 0, 0); __builtin_amdgcn_s_setprio(0); } while (0)
#define PG8_WAIT_V(n) asm volatile("s_waitcnt vmcnt(" #n ")" ::: "memory")
#define PG8_WAIT_L(n) asm volatile("s_waitcnt lgkmcnt(" #n ")" ::: "memory")
#define PG8_BAR __builtin_amdgcn_s_barrier()
#define PG8_SCHED __builtin_amdgcn_sched_barrier(0)
    Unit cur, nxt; int ui = 0;
    if (!S.next(0, cur)) return;
    f32x4 acc[2][2][4][2];
#pragma unroll
    for (int a = 0; a < 2; ++a)
#pragma unroll
        for (int b = 0; b < 2; ++b)
#pragma unroll
            for (int m = 0; m < 4; ++m)
#pragma unroll
                for (int n = 0; n < 2; ++n) acc[a][b][m][n] = (f32x4){0.f, 0.f, 0.f, 0.f};
    bf16x8 At[4][2], B0[2][2], B1[2][2];
    const size_t rstep = (size_t)K * 2;
    const char* cA = (const char*)g.A + (size_t)S.arow(cur) * rstep; const char* cB = (const char*)g.Bt + (size_t)cur.pn * tstep;
    S.a_ready(cur);
    if constexpr (SP2) {
        PG8_STAGE(PG8_SB(0, 0), cB, voffB); PG8_STAGE(PG8_SB(0, 1), cB + hstep, voffB); PG8_STAGE(PG8_SA(0, 0), cA, voffA); PG8_STAGE(PG8_SA(0, 1), cA + hstep, voffA);
        if (wr == 1) PG8_BAR;
        PG8_WAIT_V(2); PG8_BAR;
        PG8_STAGE(PG8_SB(1, 0), cB + kstep, voffB); PG8_STAGE(PG8_SA(1, 0), cA + kstep, voffA); PG8_STAGE(PG8_SB(1, 1), cB + hstep + kstep, voffB);
        PG8_WAIT_V(6); PG8_BAR;
    } else {
        PG8_STAGE(PG8_SB(0, 0), cB, voffB); PG8_STAGE(PG8_SA(0, 0), cA, voffA); PG8_STAGE(PG8_SB(0, 1), cB + hstep, voffB); PG8_STAGE(PG8_SA(0, 1), cA + hstep, voffA);
        if (wr == 1) PG8_BAR;
        PG8_WAIT_V(4); PG8_BAR;
        PG8_STAGE(PG8_SB(1, 0), cB + kstep, voffB); PG8_STAGE(PG8_SA(1, 0), cA + kstep, voffA); PG8_STAGE(PG8_SB(1, 1), cB + hstep + kstep, voffB);
        PG8_WAIT_V(6); PG8_BAR;
    }
    for (;;) {
        const bool has_next = S.next(ui + 1, nxt);
        const char* nA = has_next ? (const char*)g.A + (size_t)S.arow(nxt) * rstep : cA; const char* nB = has_next ? (const char*)g.Bt + (size_t)nxt.pn * tstep : cB;
        for (int t = 0; t < nt; t += 2) {
            const bool last = (t == nt - 2);
            if constexpr (Epi::MID) { if (t == (nt >> 1)) E.mid(acc, cur, wr, wc, fr, fq); }
            const char* a1 = cA + (size_t)(t + 1) * kstep;
            const char* a2 = last ? nA : cA + (size_t)(t + 2) * kstep; const char* b2 = last ? nB : cB + (size_t)(t + 2) * kstep;
            const char* a3 = a2 + kstep; const char* b3 = b2 + kstep;
            if (last && has_next) S.a_ready(nxt);
            if constexpr (SP2) {
            PG8_LDB(B0, 0, 0); PG8_LDB(B1, 0, 1); PG8_SCHED; PG8_LDA(At, 0, 0); PG8_STAGE(PG8_SA(1, 1), a1 + hstep, voffA);
            PG8_WAIT_V(8); PG8_WAIT_L(0); PG8_BAR; PG8_MMA(0, 0, At, B0); PG8_MMA(0, 1, At, B1); PG8_BAR; PG8_SCHED;
            PG8_LDA(At, 0, 1); PG8_STAGE(PG8_SB(0, 0), b2, voffB); PG8_STAGE(PG8_SB(0, 1), b2 + hstep, voffB); PG8_STAGE(PG8_SA(0, 0), a2, voffA);
            PG8_WAIT_V(8); PG8_WAIT_L(0); PG8_BAR; PG8_MMA(1, 0, At, B0); PG8_MMA(1, 1, At, B1); PG8_BAR; PG8_SCHED;
            PG8_LDB(B0, 1, 0); PG8_LDB(B1, 1, 1); PG8_SCHED; PG8_LDA(At, 1, 0); PG8_STAGE(PG8_SA(0, 1), a2 + hstep, voffA);
            PG8_WAIT_V(8); PG8_WAIT_L(0); PG8_BAR; PG8_MMA(0, 0, At, B0); PG8_MMA(0, 1, At, B1); PG8_BAR; PG8_SCHED;
            PG8_LDA(At, 1, 1); PG8_STAGE(PG8_SB(1, 0), b3, voffB); PG8_STAGE(PG8_SB(1, 1), b3 + hstep, voffB); PG8_STAGE(PG8_SA(1, 0), a3, voffA);
            PG8_WAIT_V(8); PG8_WAIT_L(0); PG8_BAR; PG8_MMA(1, 0, At, B0); PG8_MMA(1, 1, At, B1); PG8_BAR; PG8_SCHED;
            } else {
            PG8_LDB(B0, 0, 0); PG8_SCHED; PG8_LDA(At, 0, 0); PG8_STAGE(PG8_SA(1, 1), a1 + hstep, voffA);
            PG8_WAIT_L(8); PG8_BAR; PG8_WAIT_L(0); PG8_MMA(0, 0, At, B0); PG8_BAR; PG8_SCHED;
            PG8_LDB(B1, 0, 1); PG8_STAGE(PG8_SB(0, 0), b2, voffB);
            PG8_BAR; PG8_WAIT_L(0); PG8_MMA(0, 1, At, B1); PG8_BAR;
            PG8_LDA(At, 0, 1); PG8_STAGE(PG8_SA(0, 0), a2, voffA);
            PG8_BAR; PG8_WAIT_L(0); PG8_MMA(1, 0, At, B0); PG8_BAR; PG8_SCHED;
            PG8_STAGE(PG8_SB(0, 1), b2 + hstep, voffB);
            PG8_WAIT_V(6); PG8_BAR; PG8_MMA(1, 1, At, B1); PG8_BAR;
            PG8_LDB(B0, 1, 0); PG8_SCHED; PG8_LDA(At, 1, 0); PG8_STAGE(PG8_SA(0, 1), a2 + hstep, voffA);
            PG8_WAIT_L(8); PG8_BAR; PG8_WAIT_L(0); PG8_MMA(0, 0, At, B0); PG8_BAR; PG8_SCHED;
            PG8_LDB(B1, 1, 1); PG8_STAGE(PG8_SB(1, 0), b3, voffB);
            PG8_BAR; PG8_WAIT_L(0); PG8_MMA(0, 1, At, B1); PG8_BAR;
            PG8_LDA(At, 1, 1); PG8_STAGE(PG8_SA(1, 0), a3, voffA);
            PG8_BAR; PG8_WAIT_L(0); PG8_MMA(1, 0, At, B0); PG8_BAR; PG8_SCHED;
            PG8_STAGE(PG8_SB(1, 1), b3 + hstep, voffB);
            PG8_WAIT_V(6); PG8_BAR; PG8_MMA(1, 1, At, B1); PG8_BAR;
            }
        }
        if constexpr (ALIGN_EPI) { if (wr == 0) PG8_BAR; }
        if constexpr (!Epi::AFTER_DRAIN) { if constexpr (epi_wants_sched<Epi>::value) E.run(acc, cur, S, wr, wc, fr, fq); else E(acc, cur, wr, wc, fr, fq); S.done(cur); }
        if (!has_next) break;
#pragma unroll
        for (int a = 0; a < 2; ++a)
#pragma unroll
            for (int b = 0; b < 2; ++b)
#pragma unroll
                for (int m = 0; m < 4; ++m)
#pragma unroll
                    for (int n = 0; n < 2; ++n) acc[a][b][m][n] = (f32x4){0.f, 0.f, 0.f, 0.f};
        cur = nxt; cA = nA; cB = nB; ++ui;
        if constexpr (ALIGN_EPI) { if (wr == 1) PG8_BAR; }
    }
    PG8_WAIT_V(0);
    if constexpr (!ALIGN_EPI) { if (wr == 0) PG8_BAR; }
    PG8_BAR;
    if constexpr (Epi::AFTER_DRAIN) { E.fused(acc, cur, wr, wc, fr, fq, lds, wid, lane); S.done(cur); }
#undef PG8_SA
#undef PG8_SB
#undef PG8_STAGE
#undef PG8_LDA
#undef PG8_LDB
#undef PG8_MMA
#undef PG8_WAIT_V
#undef PG8_WAIT_L
#undef PG8_BAR
#undef PG8_SCHED
}
}

#ifndef PG8_SP2
#define PG8_SP2 true
#endif
#ifndef PG8_ALIGN
#define PG8_ALIGN true
#endif
#include <hip/hip_bf16.h>
#include <cmath>
namespace attn_body {
using bf16=__hip_bfloat16;
using bf16x8=__attribute__((ext_vector_type(8)))short;
using s16x4=__attribute__((ext_vector_type(4)))short;
using f32x16=__attribute__((ext_vector_type(16)))float;
using u32x4=__attribute__((ext_vector_type(4)))unsigned;
constexpr int BATCH=2,NHEAD=8,SEQ=8192,D=64,DM=NHEAD*D,OPITCH=1024;
constexpr int NW=8,QBLK=32,QB=QBLK*NW,KVBLK=64,NQB=SEQ/QB;
constexpr int ATTN_PITCH=DM, ATTN_UNIT_ROWS=QB;
__device__ __forceinline__ int crow(int r,int hi){return (r&3)+8*(r>>2)+4*hi;}
#define SBAR() __builtin_amdgcn_sched_barrier(0)
__device__ __forceinline__ void cmask(f32x16&p0,f32x16&p1,int jb,int qrel,int hi){
  const float NEG=-INFINITY; int kb=64*jb+4*hi;
  #pragma unroll
  for(int r=0;r<16;++r){int kv=kb+(r&3)+8*(r>>2); if(kv>qrel)p0[r]=NEG; if(kv+32>qrel)p1[r]=NEG;}
}

constexpr int NSLOT=3, SLOTB=8192;
constexpr int LDS_K=0, LDS_V=NSLOT*SLOTB, LDS_WS=2*NSLOT*SLOTB, LDS_OST=LDS_WS+NW*64*4, LDS_BYTES=LDS_OST+NW*4096;
constexpr float C2=0.125f*1.4426950408889634f;
__device__ __forceinline__ void glds16(const void*sbase,unsigned voff,unsigned lds_dst){unsigned keep;
  asm volatile("s_mov_b32 %0, m0\n\ts_mov_b32 m0, %3\n\ts_nop 0\n\tglobal_load_lds_dwordx4 %1, %2\n\ts_mov_b32 m0, %0":"=&s"(keep):"v"(voff),"s"(sbase),"s"(lds_dst):"memory");}
__device__ __forceinline__ float max3f(float a,float b,float c){float r;asm("v_max3_f32 %0, %1, %2, %3":"=v"(r):"v"(a),"v"(b),"v"(c));return r;}
__device__ __forceinline__ float max2f(float a,float b){float r;asm("v_max_f32_e32 %0, %1, %2":"=v"(r):"v"(a),"v"(b));return r;}
__device__ __forceinline__ float fadd_s(float a,float b){float r;asm("v_add_f32_e32 %0, %1, %2":"=v"(r):"v"(a),"v"(b));return r;}
__device__ __forceinline__ float fsub_s(float a,float b){float r;asm("v_sub_f32_e32 %0, %1, %2":"=v"(r):"v"(a),"v"(b));return r;}
typedef float f32x2_t __attribute__((ext_vector_type(2))); typedef __bf16 bf16x2_t __attribute__((ext_vector_type(2)));
__device__ __forceinline__ unsigned cvtpk_s(float lo,float hi){f32x2_t v={lo,hi};bf16x2_t b=__builtin_convertvector(v,bf16x2_t);return __builtin_bit_cast(unsigned,b);}
#define WAIT_BAR(N) asm volatile("s_waitcnt vmcnt(" #N ") lgkmcnt(0)\n\ts_barrier":::"memory")

__device__ __forceinline__ void qkt(f32x16&p0,f32x16&p1,const char*Kslot,const bf16x8*qr,int r32,int hi){
  const char*kb=Kslot+hi*1024+r32*16;
  #pragma unroll
  for(int d0=0;d0<4;++d0){
    const bf16x8 b0=*reinterpret_cast<const bf16x8*>(kb+d0*2048);
    const bf16x8 b1=*reinterpret_cast<const bf16x8*>(kb+d0*2048+512);
    {p0=__builtin_amdgcn_mfma_f32_32x32x16_bf16(b0,qr[d0],p0,0,0,0);p1=__builtin_amdgcn_mfma_f32_32x32x16_bf16(b1,qr[d0],p1,0,0,0);}}
}
typedef __attribute__((address_space(3))) const char* lds_cptr;
typedef short v4i16_t __attribute__((ext_vector_type(4)));
__device__ __forceinline__ void kload8(bf16x8*kf,lds_cptr kp){
  kf[0]=*(const __attribute__((address_space(3))) bf16x8*)(kp);      kf[1]=*(const __attribute__((address_space(3))) bf16x8*)(kp+512);
  kf[2]=*(const __attribute__((address_space(3))) bf16x8*)(kp+2048); kf[3]=*(const __attribute__((address_space(3))) bf16x8*)(kp+2560);
  kf[4]=*(const __attribute__((address_space(3))) bf16x8*)(kp+4096); kf[5]=*(const __attribute__((address_space(3))) bf16x8*)(kp+4608);
  kf[6]=*(const __attribute__((address_space(3))) bf16x8*)(kp+6144); kf[7]=*(const __attribute__((address_space(3))) bf16x8*)(kp+6656);
}
__device__ __forceinline__ void kload2(bf16x8*kf,lds_cptr kp,int j){ kf[2*j]=*(const __attribute__((address_space(3))) bf16x8*)(kp+j*2048); kf[2*j+1]=*(const __attribute__((address_space(3))) bf16x8*)(kp+j*2048+512); }
__device__ __forceinline__ s16x4 vtr(lds_cptr p){ return __builtin_bit_cast(s16x4,__builtin_amdgcn_ds_read_tr16_b64_v4i16((__attribute__((address_space(3))) v4i16_t*)p)); }
__device__ __forceinline__ float rowmax(const f32x16&p0,const f32x16&p1){
  float a=max3f(p0[0],p0[1],p1[0]),b=max3f(p0[2],p0[3],p1[1]);a=max3f(a,p1[2],p1[3]);
  #pragma unroll
  for(int r=4;r<16;r+=4){a=max3f(a,p0[r],p0[r+1]);b=max3f(b,p0[r+2],p0[r+3]);a=max3f(a,p1[r],p1[r+1]);b=max3f(b,p1[r+2],p1[r+3]);}
  const float m=max2f(a,b);
  auto rr=__builtin_amdgcn_permlane32_swap(__float_as_uint(m),__float_as_uint(m),false,false);
  return max2f(__uint_as_float(rr[0]),__uint_as_float(rr[1]));
}
__device__ __forceinline__ void pv(f32x16*o,int vb,bf16x8 pa0,bf16x8 pa1,bf16x8 pa2,bf16x8 pa3){
  #pragma unroll
  for(int d0=0;d0<2;++d0){s16x4 lo[4],hi[4];
    #pragma unroll
    for(int ks=0;ks<4;++ks){
      asm volatile("ds_read_b64_tr_b16 %0,%1 offset:%c2":"=&v"(lo[ks]):"v"(vb),"i"(d0*4096+ks*1024):"memory");
      asm volatile("ds_read_b64_tr_b16 %0,%1 offset:%c2":"=&v"(hi[ks]):"v"(vb),"i"(d0*4096+ks*1024+512):"memory");}
    asm volatile("s_waitcnt lgkmcnt(0)":::"memory");SBAR();
    #define PK(k) (bf16x8){lo[k][0],lo[k][1],lo[k][2],lo[k][3],hi[k][0],hi[k][1],hi[k][2],hi[k][3]}
    o[d0]=__builtin_amdgcn_mfma_f32_32x32x16_bf16(pa0,PK(0),o[d0],0,0,0);
    o[d0]=__builtin_amdgcn_mfma_f32_32x32x16_bf16(pa1,PK(1),o[d0],0,0,0);
    o[d0]=__builtin_amdgcn_mfma_f32_32x32x16_bf16(pa2,PK(2),o[d0],0,0,0);
    o[d0]=__builtin_amdgcn_mfma_f32_32x32x16_bf16(pa3,PK(3),o[d0],0,0,0);
    #undef PK
  }
}

#ifndef ATTN_STORE16
#define ATTN_STORE16(p,v) (*(u32x4*)(p)=(v))
#endif
typedef __attribute__((address_space(3))) const float* lds_fptr; typedef float f32x4a __attribute__((ext_vector_type(4)));
__device__ __forceinline__ void gload(f32x16&c0,f32x16&c1,lds_fptr g){
  #pragma unroll
  for(int q=0;q<4;++q){const f32x4a a=*(const __attribute__((address_space(3))) f32x4a*)(g+8*q),b=*(const __attribute__((address_space(3))) f32x4a*)(g+32+8*q);
    c0[4*q]=a[0];c0[4*q+1]=a[1];c0[4*q+2]=a[2];c0[4*q+3]=a[3];c1[4*q]=b[0];c1[4*q+1]=b[1];c1[4*q+2]=b[2];c1[4*q+3]=b[3];}
}
template<int THRL> __device__ __forceinline__ void attn_unit(int b,int h,int qb,const bf16*Q,const bf16*__restrict__ K,const bf16*__restrict__ V,bf16*O,char*shm,lds_fptr fk,int ts){
  const int tid=threadIdx.x,lane=tid&63,r32=lane&31,hi=lane>>5; const int wid=__builtin_amdgcn_readfirstlane(tid>>6);
  const long rowbase=(long)b*SEQ; const int q0=qb*QB;
  const bf16*Qw=Q+(rowbase+q0+wid*QBLK)*DM+h*D;
  const bf16*Kh=K+(rowbase+(long)ts*KVBLK)*DM+h*D,*Vh=V+(rowbase+(long)ts*KVBLK)*DM+h*D;
  const unsigned lds0=(unsigned)(uintptr_t)shm;
  float*wsf=(float*)(shm+LDS_WS)+wid*64;
  const bf16*ksrc=Kh+wid*8; const unsigned koff=(unsigned)lane*DM*2u;
  const bf16*vsrc=Vh+(long)(16*(wid&3))*DM+(wid>>2)*32; const unsigned voff=((unsigned)(lane>>2)*DM+(unsigned)(lane&3)*8u)*2u;
  const unsigned kdst=lds0+LDS_K+wid*1024, vdst=lds0+LDS_V+wid*1024;
  #define DMA_K(t,slot) glds16(ksrc+(long)(t)*KVBLK*DM,koff,(unsigned)__builtin_amdgcn_readfirstlane(kdst+(slot)))
  #define DMA_V(t,slot) glds16(vsrc+(long)(t)*KVBLK*DM,voff,(unsigned)__builtin_amdgcn_readfirstlane(vdst+(slot)))
  const char*Kbase=shm+LDS_K; bf16x8 kf[8];
  const lds_cptr shm3=(lds_cptr)shm; const lds_cptr kp0=shm3+LDS_K+hi*1024+r32*16; const lds_cptr vp0=shm3+LDS_V+((lane>>4)&1)*32+(lane&3)*8+(4*hi+((lane&15)>>2))*64;
  const int NT=(q0+QB)/KVBLK-ts;
  DMA_K(0,0);DMA_V(0,0);DMA_K(1,SLOTB);
  bf16x8 qr[4];
  #pragma unroll
  for(int d0=0;d0<4;++d0)qr[d0]=*reinterpret_cast<const bf16x8*>(&Qw[(long)r32*DM+d0*16+hi*8]);
  float mhat=0.f,l_reg=0.f;f32x16 o[2];o[0]=f32x16{};o[1]=f32x16{};
  #define GP0() ({ int hh_=hi; asm volatile("":"+v"(hh_)); fk+4*hh_; })
  const int qrel=wid*QBLK+r32;
  #define CMASK(P0,P1,t) do{int jb_=(t)-(NT-4); if(jb_>=0)cmask(P0,P1,jb_,qrel,hi);}while(0)
  bool resc=false;
  #define START(P0,P1) do{ const float rm=rowmax(P0,P1); resc=false; \
    { const float dl=rm; mhat=fadd_s(mhat,dl); \
      _Pragma("unroll") for(int r=0;r<16;++r){P0[r]=fsub_s(P0[r],dl);P1[r]=fsub_s(P1[r],dl);} } \
    _Pragma("unroll") for(int r=0;r<16;++r)P0[r]=__builtin_amdgcn_exp2f(P0[r]); }while(0)
  #define RESC() do{ if(resc){ asm volatile("s_waitcnt lgkmcnt(0)":::"memory"); \
      _Pragma("unroll") for(int d_=0;d_<2;++d_) _Pragma("unroll") for(int r=0;r<16;++r)o[d_][r]*=wsf[crow(r,hi)]; } }while(0)
  f32x16 pA0,pA1,pB0,pB1;
  int sl_prev=0,sl_cur=0,sl_next=SLOTB;
  #define ROT() do{sl_prev=sl_cur;sl_cur=sl_next;sl_next=(sl_next==(NSLOT-1)*SLOTB)?0:sl_next+SLOTB;}while(0)
  DMA_K(2,2*SLOTB);
  WAIT_BAR(3);
  gload(pA0,pA1,GP0()); qkt(pA0,pA1,Kbase,qr,r32,hi);asm volatile("s_nop 15\n\ts_nop 7":"+v"(pA0),"+v"(pA1));CMASK(pA0,pA1,0);
  START(pA0,pA1);
  _Pragma("unroll") for(int r=0;r<16;++r)pA1[r]=__builtin_amdgcn_exp2f(pA1[r]);
  WAIT_BAR(0);
  DMA_K(3,0);DMA_V(1,SLOTB);
  ROT();
  kload8(kf,kp0+sl_cur);
  gload(pB0,pB1,GP0()+64);
  WAIT_BAR(2);
  s16x4 vlo[8],vhi[8]; u32x4 pw0,pw1,pw2,pw3;
  #define PKW(P,B) cvtpk_s(P[B],P[B+1])
  #define PAF(k) __builtin_bit_cast(bf16x8,pw##k)
  #define VFR(i) (bf16x8){vlo[i][0],vlo[i][1],vlo[i][2],vlo[i][3],vhi[i][0],vhi[i][1],vhi[i][2],vhi[i][3]}
  #define PIN(x) asm volatile("":"+v"(x))
  #define MX3(a,b,c) __builtin_fmaxf(__builtin_fmaxf((a),(b)),(c))
  #define GAPA(MF,A0,A1,A2,A3,W0,W1,PW) do{ MF; sacc+=A0; sacc+=A1; sacc+=A2; sacc+=A3; PIN(sacc); W0; W1; PIN(PW); SBAR(); }while(0)
  #define EX(v) __builtin_amdgcn_exp2f(v)
  #define GAPB(MF,X,B) do{ MF; X[B]=EX(X[B]); X[B+1]=EX(X[B+1]); X[B+2]=EX(X[B+2]); X[B+3]=EX(X[B+3]); PIN(X); SBAR(); }while(0)
  #define VRD(i) do{ vlo[i]=vtr(vp_+(((i)>>2)*4096+((i)&3)*1024)); vhi[i]=vtr(vp_+(((i)>>2)*4096+((i)&3)*1024+512)); }while(0)
  #define KRD(G,j) do{ if(G){ kload2(kf,kp0+sl_next,j); SBAR(); } }while(0)
  #define STEP(C0,C1,P0,P1,t,GK,GV,GL) do{ SBAR(); \
    const lds_cptr vp_=vp0+sl_prev; \
    VRD(0); SBAR(); float sacc=(P0[0]+P0[1]); \
    GAPA(C0=__builtin_amdgcn_mfma_f32_32x32x16_bf16(kf[0],qr[0],C0,0,0,0), P0[2],P0[3],P0[4],P0[5],     pw0[0]=PKW(P0,0), pw0[1]=PKW(P0,2), pw0); \
    VRD(4); SBAR(); GAPA(C1=__builtin_amdgcn_mfma_f32_32x32x16_bf16(kf[1],qr[0],C1,0,0,0), P0[6],P0[7],P0[8],P0[9],     pw0[2]=PKW(P0,4), pw0[3]=PKW(P0,6), pw0); \
    VRD(1); SBAR(); GAPA(C0=__builtin_amdgcn_mfma_f32_32x32x16_bf16(kf[2],qr[1],C0,0,0,0),   P0[10],P0[11],P0[12],P0[13], pw1[0]=PKW(P0,8), pw1[1]=PKW(P0,10), pw1); \
    VRD(5); SBAR(); GAPA(C1=__builtin_amdgcn_mfma_f32_32x32x16_bf16(kf[3],qr[1],C1,0,0,0),   P0[14],P0[15],P1[0],P1[1],   pw1[2]=PKW(P0,12),pw1[3]=PKW(P0,14), pw1); \
    VRD(2); SBAR(); GAPA(C0=__builtin_amdgcn_mfma_f32_32x32x16_bf16(kf[4],qr[2],C0,0,0,0),   P1[2],P1[3],P1[4],P1[5],     pw2[0]=PKW(P1,0), pw2[1]=PKW(P1,2), pw2); \
    VRD(6); SBAR(); GAPA(C1=__builtin_amdgcn_mfma_f32_32x32x16_bf16(kf[5],qr[2],C1,0,0,0),   P1[6],P1[7],P1[8],P1[9],     pw2[2]=PKW(P1,4), pw2[3]=PKW(P1,6), pw2); \
    VRD(3); SBAR(); GAPA(C0=__builtin_amdgcn_mfma_f32_32x32x16_bf16(kf[6],qr[3],C0,0,0,0),   P1[10],P1[11],P1[12],P1[13], pw3[0]=PKW(P1,8), pw3[1]=PKW(P1,10), pw3); \
    VRD(7); SBAR(); GAPA(C1=__builtin_amdgcn_mfma_f32_32x32x16_bf16(kf[7],qr[3],C1,0,0,0),   P1[14],P1[15],0.f,0.f,       pw3[2]=PKW(P1,12),pw3[3]=PKW(P1,14), pw3); \
    l_reg+=sacc; \
    if(GK){DMA_K((t)+3,sl_cur);} if(GV){DMA_V((t)+1,sl_next);} \
    CMASK(C0,C1,t); \
    { float a=MX3(C0[0],C0[1],C1[0]),b=MX3(C0[2],C0[3],C1[1]); a=MX3(a,C1[2],C1[3]); \
      _Pragma("unroll") for(int r=4;r<16;r+=4){a=MX3(a,C0[r],C0[r+1]);b=MX3(b,C0[r+2],C0[r+3]);a=MX3(a,C1[r],C1[r+1]);b=MX3(b,C1[r+2],C1[r+3]);} \
      float rm=__builtin_fmaxf(a,b); { auto rr=__builtin_amdgcn_permlane32_swap(__float_as_uint(rm),__float_as_uint(rm),false,false); rm=__builtin_fmaxf(__uint_as_float(rr[0]),__uint_as_float(rr[1])); } \
      resc=false; const float dlt=rm-mhat; \
      if(__any(dlt>(float)THRL)){ const float dl=__builtin_fmaxf(dlt,0.f); mhat+=dl; \
        const float f=__builtin_amdgcn_exp2f(-dl); l_reg*=f; if(hi==0)wsf[r32]=f; resc=true; } \
      _Pragma("unroll") for(int r=0;r<16;++r){C0[r]-=mhat;C1[r]-=mhat;} } \
    SBAR(); \
    GAPB(o[0]=__builtin_amdgcn_mfma_f32_32x32x16_bf16(PAF(0),VFR(0),o[0],0,0,0), C0,0); \
    GAPB(o[1]=__builtin_amdgcn_mfma_f32_32x32x16_bf16(PAF(0),VFR(4),o[1],0,0,0), C0,4); \
    KRD(GL,0); GAPB(o[0]=__builtin_amdgcn_mfma_f32_32x32x16_bf16(PAF(1),VFR(1),o[0],0,0,0), C0,8); \
    KRD(GL,1); GAPB(o[1]=__builtin_amdgcn_mfma_f32_32x32x16_bf16(PAF(1),VFR(5),o[1],0,0,0), C0,12); \
    KRD(GL,2); GAPB(o[0]=__builtin_amdgcn_mfma_f32_32x32x16_bf16(PAF(2),VFR(2),o[0],0,0,0), C1,0); \
    KRD(GL,3); GAPB(o[1]=__builtin_amdgcn_mfma_f32_32x32x16_bf16(PAF(2),VFR(6),o[1],0,0,0), C1,4); \
    GAPB(o[0]=__builtin_amdgcn_mfma_f32_32x32x16_bf16(PAF(3),VFR(3),o[0],0,0,0), C1,8); \
    GAPB(o[1]=__builtin_amdgcn_mfma_f32_32x32x16_bf16(PAF(3),VFR(7),o[1],0,0,0), C1,12); \
    if(GL){ gload(P0,P1,GP0()+((t)+1)*64); } \
    }while(0)
  int t=1;
  #undef CMASK
  #define CMASK(P0,P1,t) do{}while(0)
  for(;t+5<NT;t+=2){
    STEP(pB0,pB1,pA0,pA1,t,true,true,true);     WAIT_BAR(2); RESC(); ROT();
    STEP(pA0,pA1,pB0,pB1,t+1,true,true,true);   WAIT_BAR(2); RESC(); ROT();
  }
  #undef CMASK
  #define CMASK(P0,P1,t) do{int jb_=(t)-(NT-4); if(jb_>=0)cmask(P0,P1,jb_,qrel,hi);}while(0)
  #define ENDW(tt) do{ if((tt)+3<NT){WAIT_BAR(2);} else if((tt)+2<NT){WAIT_BAR(1);} else {WAIT_BAR(0);} }while(0)
  for(;t+1<NT;t+=2){
    STEP(pB0,pB1,pA0,pA1,t,(t+3<NT),(t+1<NT),(t+1<NT));       ENDW(t);   RESC(); ROT();
    STEP(pA0,pA1,pB0,pB1,t+1,(t+4<NT),(t+2<NT),(t+2<NT));     ENDW(t+1); RESC(); ROT();
  }
  STEP(pB0,pB1,pA0,pA1,NT-1,false,false,false); RESC();
  { float sacc=pB0[0]+pB0[1]; _Pragma("unroll") for(int r=2;r<16;++r)sacc+=pB0[r]; _Pragma("unroll") for(int r=0;r<16;++r)sacc+=pB1[r]; l_reg+=sacc;
    pw0=(u32x4){PKW(pB0,0),PKW(pB0,2),PKW(pB0,4),PKW(pB0,6)};pw1=(u32x4){PKW(pB0,8),PKW(pB0,10),PKW(pB0,12),PKW(pB0,14)};pw2=(u32x4){PKW(pB1,0),PKW(pB1,2),PKW(pB1,4),PKW(pB1,6)};pw3=(u32x4){PKW(pB1,8),PKW(pB1,10),PKW(pB1,12),PKW(pB1,14)};
    SBAR(); pv(o,(int)(unsigned)(__UINTPTR_TYPE__)(vp0+sl_cur),PAF(0),PAF(1),PAF(2),PAF(3)); }
  #undef PKW
  #undef PAF
  #undef VFR
  #undef PIN
  #undef MX3
  #undef GAPA
  #undef GAPB
  #undef EX
  #undef VRD
  #undef KRD
  #undef STEP
  #undef ENDW
  {auto rr=__builtin_amdgcn_permlane32_swap(__float_as_uint(l_reg),__float_as_uint(l_reg),false,false);l_reg=__uint_as_float(rr[0])+__uint_as_float(rr[1]);}
  if(hi==0)wsf[32+r32]=l_reg;asm volatile("s_waitcnt lgkmcnt(0)":::"memory");
  float rli[16];
  #pragma unroll
  for(int r=0;r<16;++r)rli[r]=__builtin_amdgcn_rcpf(wsf[32+crow(r,hi)]);
  bf16*Ow=O+(rowbase+q0+wid*QBLK)*OPITCH+h*D;
  { bf16*stg=(bf16*)(shm+LDS_OST)+wid*2048;
    #pragma unroll
    for(int r=0;r<16;++r){const int orow=crow(r,hi);
      #pragma unroll
      for(int d0=0;d0<2;++d0)stg[orow*64+d0*32+r32]=__float2bfloat16(o[d0][r]*rli[r]);}
    asm volatile("s_waitcnt lgkmcnt(0)":::"memory");
    #pragma unroll
    for(int i=0;i<4;++i){const int row=i*8+(lane>>3),ch=lane&7; const u32x4 v=*(const u32x4*)(stg+row*64+ch*8); ATTN_STORE16(Ow+(long)row*OPITCH+ch*8,v);} }
  asm volatile("s_waitcnt lgkmcnt(0)\n\ts_barrier":::"memory");
  #undef DMA_K
  #undef DMA_V
  #undef CMASK
  #undef START
  #undef RESC
  #undef ROT
}
constexpr int ATTN_LDS_BYTES=LDS_BYTES;
struct AttnTensors { const bf16* Q; const bf16* K; const bf16* V; bf16* O; };
struct AttnUnit { int bh; int qb; };
struct StaticOrder {
  int vcu;
  __device__ __forceinline__ explicit StaticOrder(int grid,int block):vcu((block%8)*(grid/8)+block/8){}
  __device__ __forceinline__ bool next(int i,AttnUnit&u)const{ if(i>=4)return false; const int s=vcu&7; u.bh=vcu>>3; u.qb=(i==0)?s:(i==1)?15-s:(i==2)?16+s:31-s; return true; }
  __device__ __forceinline__ void a_ready(const AttnUnit&)const{}
  __device__ __forceinline__ void done(const AttnUnit&)const{}
};
#undef SBAR
#undef WAIT_BAR
}
namespace cg = cooperative_groups;
#ifndef MK_COOP
#define MK_COOP 1
#endif
constexpr int NWAVES = 8;
constexpr int BATCH = 2, T = 8192, D = 1024, M = BATCH * T, NH = 8, HD = 64, CW = 512, DFF = 2816, NUP = 2 * DFF, NIN = 5120, INW = 5128, NMOD = 6 * D;
constexpr float RMS_EPS = 1e-6f, LOG2E = 1.4426950408889634f;
constexpr int N_PHASES = 12;
constexpr size_t MiB = 1u << 20;
constexpr size_t WS_CTL = 0, CTL_ZERO_BYTES = 81920;
constexpr size_t WS_MODACC = 4096, WS_SSQ = 131072, WS_CVEC = 262144;
constexpr size_t WS_UNITCTR = 512, WS_UINFO = 524288;
constexpr size_t WS_LF = 1 * MiB, WS_G = WS_LF + 512 * 1024;
constexpr size_t WS_WIN = 2 * MiB, WS_WAB = 12 * MiB, WS_WOUT = 14 * MiB, WS_WUP = 16 * MiB, WS_WDN = 27 * MiB;
constexpr size_t WS_XN = 34 * MiB, WS_YAB = WS_XN;
constexpr size_t WS_CB = 66 * MiB, WS_CC = 82 * MiB, WS_CV = 98 * MiB, WS_Q = 114 * MiB, WS_K = 130 * MiB, WS_V = 146 * MiB, WS_GA = 162 * MiB, WS_GB = 194 * MiB;
constexpr size_t WS_MERGED = 66 * MiB;
constexpr size_t WS_UH = 66 * MiB, WS_ACT = 154 * MiB, WS_END = 242 * MiB;
static_assert(WS_WDN + (size_t)D * DFF * 2 <= WS_XN && WS_UH + (size_t)T * NUP * 2 <= WS_ACT && WS_ACT + (size_t)M * DFF * 2 <= WS_END, "ws map");

#define LAS __attribute__((address_space(3)))
typedef unsigned short bfu;
typedef unsigned v4u __attribute__((ext_vector_type(4)));
typedef float f32x4 __attribute__((ext_vector_type(4)));
#define LDS_WAIT() asm volatile("s_waitcnt lgkmcnt(0)" ::: "memory")
__device__ __forceinline__ unsigned f2bf(float f) { unsigned u = __builtin_bit_cast(unsigned, f); return (u + 0x7fffu + ((u >> 16) & 1u)) >> 16; }
__device__ __forceinline__ unsigned pk2(float lo, float hi) { unsigned r; asm("v_cvt_pk_bf16_f32 %0, %1, %2" : "=v"(r) : "v"(lo), "v"(hi)); return r; }
__device__ __forceinline__ float blo(unsigned w) { return __uint_as_float(w << 16); }
__device__ __forceinline__ float bhi(unsigned w) { return __uint_as_float(w & 0xffff0000u); }
__device__ __forceinline__ float wave_sum(float v) {
#pragma unroll
    for (int o = 1; o < 64; o <<= 1) v += __shfl_xor(v, o);
    return v;
}
__device__ __forceinline__ float siluf_(float x) { return x * __builtin_amdgcn_rcpf(1.0f + __expf(-x)); }

#define XB_TMO      128
#define XB_XCNT(j)  (256  + 64 * (j))
#define XB_XSUB(j)  (1280 + 64 * (j))
#define XB_XGEN(j)  (2304 + 64 * (j))
#define XB_TOP      3328
#define XB_TOPGEN   3392
#define XCD_BAR_WORDS 3456
#define XB_SPIN_CAP (1u << 18)

__device__ __forceinline__ unsigned xb_ld(unsigned* p)              { return __hip_atomic_load(p, __ATOMIC_RELAXED, __HIP_MEMORY_SCOPE_AGENT); }
__device__ __forceinline__ unsigned xb_add(unsigned* p, unsigned v) { return __hip_atomic_fetch_add(p, v, __ATOMIC_RELAXED, __HIP_MEMORY_SCOPE_AGENT); }
__device__ __forceinline__ unsigned xb_xcc_id() { return (unsigned)__builtin_amdgcn_s_getreg((3 << 11) | 20) & 0xFu; }
#define XB_SPIN(cond, bar) do { unsigned _sp = 0; while (cond) { __builtin_amdgcn_s_sleep(1); \
    if ((++_sp & 255u) == 0u) { if (xb_ld(&(bar)[XB_TMO])) break; if (_sp > XB_SPIN_CAP) { atomicAdd(&(bar)[XB_TMO], 1u); break; } } } } while (0)

struct XcdBarrier {
    unsigned* bar; unsigned x;
    volatile LAS unsigned* st;
};

__device__ __forceinline__ XcdBarrier xcd_barrier_post(unsigned* bar, volatile LAS unsigned* st) {
    XcdBarrier b; b.bar = bar; b.x = xb_xcc_id(); b.st = st;
    if (threadIdx.x == 0) (void)xb_add(&bar[XB_XCNT(b.x)], 1u);
    return b;
}
__device__ __forceinline__ void xcd_barrier_complete(unsigned* bar, unsigned x, unsigned& nloc, unsigned& nx) {
    const unsigned G = gridDim.x * gridDim.y * gridDim.z;
    unsigned sum, cnt, mine, sp = 0u;
    for (;;) {
        sum = 0u; cnt = 0u; mine = 0u;
#pragma unroll
        for (unsigned j = 0; j < 16; ++j) { const unsigned c = xb_ld(&bar[XB_XCNT(j)]); sum += c; cnt += (c > 0u) ? 1u : 0u; mine = (j == x) ? c : mine; }
        if (sum == G) break;
        __builtin_amdgcn_s_sleep(1);
        if ((++sp & 255u) == 0u) { if (xb_ld(&bar[XB_TMO])) break; if (sp > XB_SPIN_CAP) { atomicAdd(&bar[XB_TMO], 1u); break; } }
    }
    nloc = mine > 0u ? mine : 1u; nx = cnt > 0u ? cnt : 1u;
}

__device__ __forceinline__ void xcd_barrier(const XcdBarrier& b) {
    asm volatile("s_waitcnt vmcnt(0)" ::: "memory");
    __syncthreads();
    if (threadIdx.x == 0) {
        unsigned* bar = b.bar;
        __builtin_amdgcn_s_waitcnt(0);
        unsigned nloc = b.st[0], nx = b.st[1];
        if (nloc == 0u) { xcd_barrier_complete(bar, b.x, nloc, nx); b.st[0] = nloc; b.st[1] = nx; }
        const unsigned old = xb_add(&bar[XB_XSUB(b.x)], 1u);
        const unsigned gen = old / nloc;
        if (old + 1u == (gen + 1u) * nloc) {
            __builtin_amdgcn_fence(__ATOMIC_RELEASE, "agent");
            asm volatile("s_waitcnt vmcnt(0)" ::: "memory");
            const unsigned og = xb_add(&bar[XB_TOP], 1u);
            const unsigned tg = og / nx;
            if (og + 1u == (tg + 1u) * nx) xb_add(&bar[XB_TOPGEN], 1u);
            else XB_SPIN(xb_ld(&bar[XB_TOPGEN]) == tg, bar);
            __builtin_amdgcn_fence(__ATOMIC_ACQUIRE, "agent");
            xb_add(&bar[XB_XGEN(b.x)], 1u);
            asm volatile("s_waitcnt vmcnt(0)" ::: "memory");
        } else {
            XB_SPIN(xb_ld(&bar[XB_XGEN(b.x)]) == gen, bar);
            __builtin_amdgcn_fence(__ATOMIC_ACQUIRE, "agent");
            asm volatile("s_waitcnt vmcnt(0)" ::: "memory");
        }
    }
    __syncthreads();
}
__device__ __forceinline__ void grid_bar(unsigned* ctr, unsigned target) {
    asm volatile("s_waitcnt vmcnt(0) lgkmcnt(0)" ::: "memory");
    __syncthreads();
    if (threadIdx.x == 0) {
        __builtin_amdgcn_fence(__ATOMIC_RELEASE, "agent");
        asm volatile("s_waitcnt vmcnt(0)" ::: "memory");
        __hip_atomic_fetch_add(ctr, 1u, __ATOMIC_RELAXED, __HIP_MEMORY_SCOPE_AGENT);
        while (__hip_atomic_load(ctr, __ATOMIC_RELAXED, __HIP_MEMORY_SCOPE_AGENT) < target) __builtin_amdgcn_s_sleep(2);
        __builtin_amdgcn_fence(__ATOMIC_ACQUIRE, "agent");
        asm volatile("s_waitcnt vmcnt(0)" ::: "memory");
    }
    __syncthreads();
}
struct Args { const float* in[17]; float* out; unsigned char* ws; int ph_lo, ph_hi; };
enum { I_X = 0, I_C, I_WADA, I_BADA, I_N1G, I_WIN, I_BF, I_CONVA, I_QG, I_KG, I_WBA, I_WBB, I_WOUT, I_N2G, I_WUP, I_CONVF, I_WDN };

__device__ __forceinline__ void transpose_item(const float* W, int ldw, int k0, int c0, bfu* WT, int K, int dk0, int drow0, LAS float* scr, int lane) {
    { const int kr = lane >> 3, nc = (lane & 7) * 4; f32x4 v[8];
#pragma unroll
      for (int i = 0; i < 8; ++i) v[i] = __builtin_nontemporal_load((const f32x4*)(W + (size_t)(k0 + 8 * i + kr) * ldw + c0 + nc));
#pragma unroll
      for (int i = 0; i < 8; ++i) { LAS float* d = scr + (8 * i + kr) * 33 + nc; d[0] = v[i].x; d[1] = v[i].y; d[2] = v[i].z; d[3] = v[i].w; } }
    LDS_WAIT(); asm volatile("" ::: "memory");
    const int c = lane & 7;
#pragma unroll
    for (int j = 0; j < 4; ++j) { const int n = (lane >> 3) + 8 * j; const LAS float* s = scr + (8 * c) * 33 + n;
        v4u o; o.x = pk2(s[0 * 33], s[1 * 33]); o.y = pk2(s[2 * 33], s[3 * 33]); o.z = pk2(s[4 * 33], s[5 * 33]); o.w = pk2(s[6 * 33], s[7 * 33]);
        *(v4u*)(WT + (size_t)(drow0 + n) * K + dk0 + 8 * c) = o; }
    LDS_WAIT(); asm volatile("" ::: "memory");
}

template <int NK = 64> __device__ __forceinline__ void gemv2_item(const float* W, int ldw, int n0, int k0, float c0, float c1, float* out0, float* out1, int lane) {
    f32x4 s0 = {0.f, 0.f, 0.f, 0.f}, s1 = {0.f, 0.f, 0.f, 0.f};
    const float* wp = W + (size_t)k0 * ldw + n0 + 4 * lane;
#pragma unroll 16
    for (int kk = 0; kk < NK; ++kk) { const f32x4 w = __builtin_nontemporal_load((const f32x4*)(wp + (size_t)kk * ldw)); s0 += w * __shfl(c0, kk); s1 += w * __shfl(c1, kk); }
    float* o0 = out0 + n0 + 4 * lane; float* o1 = out1 + n0 + 4 * lane;
    atomicAdd(o0, s0.x); atomicAdd(o0 + 1, s0.y); atomicAdd(o0 + 2, s0.z); atomicAdd(o0 + 3, s0.w);
    atomicAdd(o1, s1.x); atomicAdd(o1 + 1, s1.y); atomicAdd(o1 + 2, s1.z); atomicAdd(o1 + 3, s1.w);
}
template <bool FLOG>
__device__ __forceinline__ void norm_rows(const float* X, const float* gain, const float* modacc, const float* bada, int sh_slot, int sc_slot, bfu* XN, const LAS float* wf, const float* bf_, float* LF, int gw, int NGW, int lane) {
    for (int m0 = gw * 8; m0 < M; m0 += NGW * 8) {
        const int b = m0 / T;
        f32x4 A[4], Bv[4];
#pragma unroll
        for (int j = 0; j < 4; ++j) { const int col = 256 * j + 4 * lane;
            const f32x4 g = *(const f32x4*)(gain + col);
            const f32x4 sc = *(const f32x4*)(modacc + b * NMOD + sc_slot * D + col) + *(const f32x4*)(bada + sc_slot * D + col);
            const f32x4 sh = *(const f32x4*)(modacc + b * NMOD + sh_slot * D + col) + *(const f32x4*)(bada + sh_slot * D + col);
            A[j] = g * (sc + 1.0f); Bv[j] = sh; }
        f32x4 vv[2][4][4];
#pragma unroll
        for (int g = 0; g < 2; ++g)
#pragma unroll
            for (int q = 0; q < 4; ++q) { const f32x4* xr = (const f32x4*)(X + (size_t)(m0 + 4 * g + q) * D) + lane;
#pragma unroll
                for (int j = 0; j < 4; ++j) vv[g][q][j] = __builtin_nontemporal_load(xr + 64 * j); }
#pragma unroll
        for (int g = 0; g < 2; ++g) { const int r0 = 4 * g;
            f32x4 (&v)[4][4] = vv[g]; float s2[4];
#pragma unroll
            for (int q = 0; q < 4; ++q) { s2[q] = 0.f;
#pragma unroll
                for (int j = 0; j < 4; ++j) s2[q] += (v[q][j].x * v[q][j].x + v[q][j].y * v[q][j].y) + (v[q][j].z * v[q][j].z + v[q][j].w * v[q][j].w); }
#pragma unroll
            for (int o = 1; o < 64; o <<= 1) {
#pragma unroll
                for (int q = 0; q < 4; ++q) s2[q] += __shfl_xor(s2[q], o); }
#pragma unroll
            for (int q = 0; q < 4; ++q) { const int m = m0 + r0 + q;
                const float inv = __builtin_amdgcn_rsqf(s2[q] * (1.0f / D) + RMS_EPS);
                unsigned long long* o8 = (unsigned long long*)(XN + (size_t)m * D) + lane;
#pragma unroll
                for (int j = 0; j < 4; ++j) { v[q][j] = v[q][j] * inv * A[j] + Bv[j];
                    o8[64 * j] = (unsigned long long)pk2(v[q][j].x, v[q][j].y) | ((unsigned long long)pk2(v[q][j].z, v[q][j].w) << 32); }
                if (FLOG) {
                    asm volatile("" ::: "memory");
                    float p[8];
#pragma unroll
                    for (int h = 0; h < 8; ++h) { p[h] = 0.f;
#pragma unroll
                        for (int j = 0; j < 4; ++j) { const f32x4 w = *(const LAS f32x4*)(wf + h * D + 256 * j + 4 * lane); p[h] += (v[q][j].x * w.x + v[q][j].y * w.y) + (v[q][j].z * w.z + v[q][j].w * w.w); } }
#pragma unroll
                    for (int h = 0; h < 4; ++h) { const float send = (lane & 1) ? p[h] : p[h + 4], keep = (lane & 1) ? p[h + 4] : p[h]; p[h] = keep + __shfl_xor(send, 1); }
#pragma unroll
                    for (int h = 0; h < 2; ++h) { const float send = (lane & 2) ? p[h] : p[h + 2], keep = (lane & 2) ? p[h + 2] : p[h]; p[h] = keep + __shfl_xor(send, 2); }
                    { const float send = (lane & 4) ? p[0] : p[1], keep = (lane & 4) ? p[1] : p[0]; p[0] = keep + __shfl_xor(send, 4); }
                    p[0] += __shfl_xor(p[0], 8); p[0] += __shfl_xor(p[0], 16); p[0] += __shfl_xor(p[0], 32);
                    if (lane < 8) { const int h = ((lane & 1) << 2) | (lane & 2) | ((lane & 4) >> 2); const float z = p[0] + bf_[h]; LF[(size_t)((m / T) * 8 + h) * T + (m % T)] = fminf(z, 0.f) - log1pf(__expf(-fabsf(z))); }
                }
            }
        }
    }
}

__global__ void __launch_bounds__(NWAVES * 64, 2) fwd_kernel(Args args) {
    extern __shared__ __attribute__((aligned(16))) unsigned char lds[];
    LAS unsigned char* ldsp = (LAS unsigned char*)lds;
    const int wave = __builtin_amdgcn_readfirstlane((int)threadIdx.x >> 6);
    const int G = gridDim.x; const int bx = blockIdx.x; const int vcu = (G % 8 == 0) ? (bx % 8) * (G / 8) + bx / 8 : bx;
    const int gw = vcu * NWAVES + wave, NGW = G * NWAVES;
#define PH_IDS int tid = threadIdx.x; asm volatile("" : "+v"(tid)); const int lane = tid & 63; (void)lane
    unsigned char* ws = args.ws;
    float* modacc = (float*)(ws + WS_MODACC);
    float* ssq = (float*)(ws + WS_SSQ); float* cvec = (float*)(ws + WS_CVEC);
    float* LF = (float*)(ws + WS_LF); float* GF = (float*)(ws + WS_G);
    bfu *Win_t = (bfu*)(ws + WS_WIN), *Wab_t = (bfu*)(ws + WS_WAB), *Wout_t = (bfu*)(ws + WS_WOUT), *Wup_t = (bfu*)(ws + WS_WUP), *Wdn_t = (bfu*)(ws + WS_WDN);
    bfu *XN = (bfu*)(ws + WS_XN), *YAB = (bfu*)(ws + WS_YAB), *CB = (bfu*)(ws + WS_CB), *CC = (bfu*)(ws + WS_CC), *CV = (bfu*)(ws + WS_CV);
    bfu *QB = (bfu*)(ws + WS_Q), *KB = (bfu*)(ws + WS_K), *VB = (bfu*)(ws + WS_V), *GA = (bfu*)(ws + WS_GA), *GB = (bfu*)(ws + WS_GB);
    bfu* X1B = (bfu*)(ws + 100 * MiB);
    bfu *MERGED = (bfu*)(ws + WS_MERGED), *UH = (bfu*)(ws + WS_UH), *ACT = (bfu*)(ws + WS_ACT);
    const float* x = args.in[I_X]; float* out = args.out; const float* bada = args.in[I_BADA];
    const int lo = args.ph_lo, hi = args.ph_hi;
#ifndef PHMASK
#define PHMASK 0xfff
#endif
#define IN(k) (((PHMASK >> (k)) & 1) && lo <= (k) && (k) < hi)
    { volatile LAS unsigned* misc = (volatile LAS unsigned*)(ldsp + 146432); if (threadIdx.x < 2) misc[threadIdx.x] = 0u; __syncthreads(); }
    if (args.ph_lo < 0) cg::this_grid().sync();
    const XcdBarrier xbar = xcd_barrier_post((unsigned*)(ws + WS_CTL + 65536), (volatile LAS unsigned*)(ldsp + 146432));
    unsigned* barctr = (unsigned*)(ws + WS_CTL + 256);
#define SEAM(k) do { if (IN(k) && (IN((k) + 1) || ((k) == 5 && IN(7)) || ((k) == 7 && IN(11)))) { xcd_barrier(xbar); } } while (0)

    if (IN(0)) {
        PH_IDS;
        for (int i = (vcu * NWAVES * 64) + tid; i < M; i += G * NWAVES * 64) ssq[i] = 0.f;
        for (int r = gw; r < 24 * 64; r += NGW) {
            const int nb = r % 24, kc = r / 24, k0 = kc * 16; const float* c = args.in[I_C];
            gemv2_item<16>(args.in[I_WADA], NMOD, nb * 256, k0, siluf_(c[k0 + (lane & 15)]), siluf_(c[D + k0 + (lane & 15)]), modacc, modacc + NMOD, lane);
        }
    }
    SEAM(0);
    if (IN(1)) {
        PH_IDS;
        LAS float* wf = (LAS float*)ldsp;
        for (int k = tid; k < D; k += NWAVES * 64) { const float* src = args.in[I_WIN] + (size_t)k * INW + 3072; const f32x4 a = *(const f32x4*)src, b = *(const f32x4*)(src + 4);
            wf[0 * D + k] = a.x; wf[1 * D + k] = a.y; wf[2 * D + k] = a.z; wf[3 * D + k] = a.w; wf[4 * D + k] = b.x; wf[5 * D + k] = b.y; wf[6 * D + k] = b.z; wf[7 * D + k] = b.w; }
        __syncthreads();
        norm_rows<true>(x, args.in[I_N1G], modacc, bada, 0, 1, XN, wf, args.in[I_BF], LF, gw, NGW, lane);
        {
            LAS float* scr = (LAS float*)(ldsp + 32768 + wave * 8448);
            constexpr int I_IN = 16 * 160, I_AB = 16 * 32, I_OUT = 16 * 32, I_UP = 16 * 176, I_DN = 44 * 32;
            constexpr int NITEMS = I_IN + I_AB + I_OUT + I_UP + I_DN;
            for (int it = gw; it < NITEMS; it += NGW) {
                int r = it;
                if (r < I_IN) { const int kb = r / 160, db = r % 160, d0 = 32 * db, pn = d0 >> 8, s = d0 & 255;
                    int srcs = s; if (pn >= 6 && pn < 10) { const int bj = s >> 7, wc = (s >> 5) & 3; srcs = 64 * wc + 32 * bj; }
                    int col = 256 * pn + srcs; if (pn >= 12) col = 3072 + (s >> 7) * 1024 + 128 * (pn - 12) + (s & 127);
                    if (col >= 3072) col += 8;
                    transpose_item(args.in[I_WIN], INW, 64 * kb, col, Win_t, D, 64 * kb, d0, scr, lane); continue; }
                r -= I_IN;
                if (r < I_AB) { const int kb = r / 32, nb = r % 32;
                    transpose_item(kb < 8 ? args.in[I_WBA] : args.in[I_WBB], D, 64 * (kb & 7), 32 * nb, Wab_t, D, 64 * kb, 32 * nb, scr, lane); continue; }
                r -= I_AB;
                if (r < I_OUT) { const int kb = r / 32, nb = r % 32; transpose_item(args.in[I_WOUT], D, 64 * kb, 32 * nb, Wout_t, D, 64 * kb, 32 * nb, scr, lane); continue; }
                r -= I_OUT;
                if (r < I_UP) { const int kb = r / 176, nb = r % 176, d0 = 32 * nb; const int col = ((d0 & 255) >> 7) * DFF + 128 * (d0 >> 8) + (d0 & 127);
                    transpose_item(args.in[I_WUP], NUP, 64 * kb, col, Wup_t, D, 64 * kb, d0, scr, lane); continue; }
                r -= I_UP;
                { const int kb = r / 32, nb = r % 32; transpose_item(args.in[I_WDN], D, 64 * kb, 32 * nb, Wdn_t, DFF, 64 * kb, 32 * nb, scr, lane); }
            }
        }
        __syncthreads();
    }
    SEAM(1);
    if (IN(2)) {
        PH_IDS;
        if (bx < 16) {
            LAS float* tot = (LAS float*)(ldsp + 140 * 1024);
            const int t0 = wave * 1024 + lane * 16;
            float v[16];
            { const f32x4* lf4 = (const f32x4*)(LF + (size_t)bx * T + t0);
#pragma unroll
              for (int j = 0; j < 4; ++j) { const f32x4 q = lf4[j]; v[4 * j] = q.x; v[4 * j + 1] = q.y; v[4 * j + 2] = q.z; v[4 * j + 3] = q.w; } }
#pragma unroll
            for (int j = 1; j < 16; ++j) v[j] += v[j - 1];
            float incl = v[15];
#pragma unroll
            for (int o = 1; o < 64; o <<= 1) { const float y = __shfl_up(incl, o); if (lane >= o) incl += y; }
            const float excl = incl - v[15];
            if (lane == 63) tot[wave] = incl;
            __syncthreads();
            float off = 0.f;
            for (int w = 0; w < wave; ++w) off += tot[w];
#pragma unroll
            for (int j = 0; j < 16; ++j) GF[(size_t)bx * T + t0 + j] = -(off + excl + v[j]) * LOG2E;
            LAS float* Gl = (LAS float*)ldsp;
#pragma unroll
            for (int j = 0; j < 16; ++j) Gl[t0 + j] = -(off + excl + v[j]) * LOG2E;
            float cthr;
            { const float gq = fabsf(args.in[I_QG][lane]), gk = fabsf(args.in[I_KG][lane]); float mq = gq, mk = gk;
#pragma unroll
              for (int o = 1; o < 64; o <<= 1) { mq = fmaxf(mq, __shfl_xor(mq, o)); mk = fmaxf(mk, __shfl_xor(mk, o)); }
              cthr = 2.0f * (8.0f * mq * mk * 1.02f * LOG2E) + 32.0f; }
            __syncthreads();
            if (tid < 32) { const int qb = tid, NT = 4 * (qb + 1); const float gq0 = Gl[256 * qb]; int lo_ = 0, hi_ = NT / 2 - 2;
                while (lo_ < hi_) { const int mid = (lo_ + hi_ + 1) >> 1; if (gq0 - Gl[128 * mid - 1] > cthr) lo_ = mid; else hi_ = mid - 1; }
                ((int*)(ws + WS_UINFO))[bx * 32 + qb] = 2 * lo_; }
            __syncthreads();
        }
        pg8::Gemm g{XN, Win_t, M, NIN, D}; pg8::StaticOrder S; S.init(M, NIN, G, bx);
        pg8::EpiIn E{CB, (size_t)(16 * MiB / 2), (size_t)((WS_GA - WS_CB) / 2), (size_t)(32 * MiB / 2), args.in[I_QG], (long)(args.in[I_KG] - args.in[I_QG]), 0.125f * LOG2E, RMS_EPS};
        pg8::gemm_phase<pg8::EpiIn, pg8::StaticOrder, true, true>(ldsp, g, S, E);
    }
    SEAM(2);
    if (IN(3)) {
        PH_IDS;
        LAS float* fk = (LAS float*)(ldsp + 86016);
        LAS int* ucost = (LAS int*)(ldsp + 122880); LAS int* uord = ucost + 512; LAS int* slot = uord + 512;
        { const int u = tid; ucost[u] = 4 * ((u & 31) + 1) - ((const int*)(ws + WS_UINFO))[u]; }
        __syncthreads();
        { const int my = ucost[tid]; int rank = 0;
          for (int j = 0; j < 512; ++j) { const int c = ucost[j]; rank += (c > my || (c == my && j < tid)) ? 1 : 0; }
          uord[rank] = tid; }
        __syncthreads();
        for (;;) {
            if (threadIdx.x == 0) slot[0] = (int)__hip_atomic_fetch_add((unsigned*)(ws + WS_UNITCTR), 1u, __ATOMIC_RELAXED, __HIP_MEMORY_SCOPE_AGENT);
            __syncthreads();
            const int p = __builtin_amdgcn_readfirstlane(slot[0]);
            __syncthreads();
            if (p >= 512) break;
            const int u = __builtin_amdgcn_readfirstlane(uord[p]), bh = u >> 5, qb = u & 31, ts = __builtin_amdgcn_readfirstlane(4 * (qb + 1) - ucost[u]);
            const f32x4* gsrc = (const f32x4*)(GF + (size_t)bh * T);
            int t2 = threadIdx.x; asm volatile("" : "+v"(t2));
            for (int i = t2 + 16 * ts; i < (qb + 1) * 64; i += NWAVES * 64) ((LAS f32x4*)fk)[i] = gsrc[i];
            __syncthreads();
            attn_body::attn_unit<20>(bh >> 3, bh & 7, qb, (const attn_body::bf16*)QB, (const attn_body::bf16*)KB, (const attn_body::bf16*)VB, (attn_body::bf16*)(YAB + CW), (char*)lds, fk + 64 * ts, ts);
        }
        { int t3 = threadIdx.x; asm volatile("" : "+v"(t3)); const int lane = t3 & 63;
          const float* cw = args.in[I_CONVA];
          for (;;) {
            if (t3 == 0) slot[0] = (int)__hip_atomic_fetch_add((unsigned*)(ws + WS_UNITCTR + 128), 1u, __ATOMIC_RELAXED, __HIP_MEMORY_SCOPE_AGENT);
            __syncthreads();
            const int q = __builtin_amdgcn_readfirstlane(slot[0]);
            __syncthreads();
            if (q >= 344) break;
            if (q >= 256) {
                float s0[16], s1[16];
#pragma unroll
                for (int i = 0; i < 16; ++i) { const int k = 16 * lane + i; const float bb = bada[3 * D + k]; s0[i] = modacc[3 * D + k] + bb; s1[i] = modacc[NMOD + 3 * D + k] + bb; }
                for (int r = 0; r < 8; ++r) { const int n = 64 * (q - 256) + 8 * wave + r;
                    const v4u wa = *(const v4u*)(Wup_t + (size_t)n * D + 16 * lane), wb = *(const v4u*)(Wup_t + (size_t)n * D + 16 * lane + 8);
                    float a0 = 0.f, a1 = 0.f;
#pragma unroll
                    for (int i = 0; i < 4; ++i) { const float w0 = blo(wa[i]), w1 = bhi(wa[i]), w2 = blo(wb[i]), w3 = bhi(wb[i]);
                        a0 += w0 * s0[2 * i] + w1 * s0[2 * i + 1] + w2 * s0[8 + 2 * i] + w3 * s0[8 + 2 * i + 1];
                        a1 += w0 * s1[2 * i] + w1 * s1[2 * i + 1] + w2 * s1[8 + 2 * i] + w3 * s1[8 + 2 * i + 1]; }
                    a0 = wave_sum(a0); a1 = wave_sum(a1);
                    if (lane == 0) { cvec[n] = a0; cvec[NUP + n] = a1; } }
                continue;
            }
            const int m0 = 64 * q + 8 * wave;
            {
            const int t0 = m0 % T, col = lane * 8;
            float w0[8], w1[8], w2[8], p2[8], p1[8];
#pragma unroll
            for (int i = 0; i < 8; ++i) { w0[i] = cw[col + i]; w1[i] = cw[CW + col + i]; w2[i] = cw[2 * CW + col + i]; p2[i] = 0.f; p1[i] = 0.f; }
            if (t0 != 0) {
                const v4u a2 = *(const v4u*)(CC + (size_t)(m0 - 2) * CW + col), b2 = *(const v4u*)(CV + (size_t)(m0 - 2) * CW + col);
                const v4u a1 = *(const v4u*)(CC + (size_t)(m0 - 1) * CW + col), b1 = *(const v4u*)(CV + (size_t)(m0 - 1) * CW + col);
#pragma unroll
                for (int i = 0; i < 4; ++i) { p2[2 * i] = blo(a2[i]) * blo(b2[i]); p2[2 * i + 1] = bhi(a2[i]) * bhi(b2[i]); p1[2 * i] = blo(a1[i]) * blo(b1[i]); p1[2 * i + 1] = bhi(a1[i]) * bhi(b1[i]); }
            }
#pragma unroll
            for (int r = 0; r < 8; ++r) { const size_t m = (size_t)(m0 + r);
                const v4u a = *(const v4u*)(CC + m * CW + col), b = *(const v4u*)(CV + m * CW + col), cbv = *(const v4u*)(CB + m * CW + col);
                float cur[8], y[8];
#pragma unroll
                for (int i = 0; i < 4; ++i) { cur[2 * i] = blo(a[i]) * blo(b[i]); cur[2 * i + 1] = bhi(a[i]) * bhi(b[i]); }
#pragma unroll
                for (int i = 0; i < 8; ++i) { const float cbf = (i & 1) ? bhi(cbv[i >> 1]) : blo(cbv[i >> 1]); y[i] = cbf * (w0[i] * p2[i] + w1[i] * p1[i] + w2[i] * cur[i]); p2[i] = p1[i]; p1[i] = cur[i]; }
                v4u o; o.x = pk2(y[0], y[1]); o.y = pk2(y[2], y[3]); o.z = pk2(y[4], y[5]); o.w = pk2(y[6], y[7]);
                *(v4u*)(YAB + m * D + col) = o; }
            }
          }
        }
    }
    SEAM(3);
    if (IN(4)) {
        pg8::Gemm g{YAB, Wab_t, M, D, D}; pg8::StaticOrder S; S.init(M, D, G, bx);
        pg8::EpiMerged E{GA, GB, MERGED};
        pg8::gemm_phase<pg8::EpiMerged, pg8::StaticOrder, true, true>(ldsp, g, S, E);
    }
    SEAM(4);
    if (IN(5)) {
        pg8::Gemm g{MERGED, Wout_t, M, D, D}; pg8::StaticOrder S; S.init(M, D, G, bx);
        pg8::EpiRes<true> E{x, out, modacc + 2 * D, bada + 2 * D, T, NMOD, XN, args.in[I_N2G], modacc + 4 * D, bada + 4 * D, ssq, X1B};
        pg8::gemm_phase<pg8::EpiRes<true>, pg8::StaticOrder, true, true>(ldsp, g, S, E);
    }
    SEAM(5);
    if (IN(7)) {
        pg8::Gemm g{XN, Wup_t, M, NUP, D}; pg8::HaloOrder S; S.init(BATCH, NUP, G, bx);
        pg8::EpiUpConv E{ACT, ssq, cvec, args.in[I_CONVF], (LAS float*)(ldsp + 131072), 1.0f / D, RMS_EPS, DFF, NUP, T};
        pg8::gemm_phase<pg8::EpiUpConv, pg8::HaloOrder, true, true>(ldsp, g, S, E);
    }
    SEAM(7);
    if (IN(11)) {
        pg8::Gemm g{ACT, Wdn_t, M, D, DFF}; pg8::StaticOrder S; S.init(M, D, G, bx);
        pg8::EpiRes<false> E{nullptr, out, modacc + 5 * D, bada + 5 * D, T, NMOD, nullptr, nullptr, nullptr, nullptr, nullptr, X1B};
        pg8::gemm_phase<pg8::EpiRes<false>, pg8::StaticOrder, true, true>(ldsp, g, S, E);
    }
#undef IN
#undef SEAM
}

constexpr int LDS_BYTES = 147456;
extern "C" void kernel_launch(void* const* d_in, const int* in_sizes, int n_in, void* d_out, int out_size, void* d_ws, size_t ws_size, hipStream_t stream) {
    static int grid = 0;
    if (grid == 0) {
        if (n_in != 17 || out_size != M * D || ws_size < WS_END) { fprintf(stderr, "kernel_launch: unexpected shapes (n_in %d out %d ws %zu)\n", n_in, out_size, ws_size); grid = -1; return; }
        int dev = 0, cus = 0, per_cu = 0;
        (void)hipGetDevice(&dev); (void)hipDeviceGetAttribute(&cus, hipDeviceAttributeMultiprocessorCount, dev);
        (void)hipFuncSetAttribute((const void*)fwd_kernel, hipFuncAttributeMaxDynamicSharedMemorySize, LDS_BYTES);
        (void)hipOccupancyMaxActiveBlocksPerMultiprocessor(&per_cu, (const void*)fwd_kernel, NWAVES * 64, LDS_BYTES);
        if (per_cu < 1) per_cu = 1;
        (void)hipGetLastError();
        grid = cus * per_cu;
    }
    if (grid < 0) return;
    (void)hipMemsetAsync((char*)d_ws + WS_CTL, 0, CTL_ZERO_BYTES, stream);
    Args a{};
    for (int i = 0; i < 17; ++i) a.in[i] = (const float*)d_in[i];
    a.out = (float*)d_out; a.ws = (unsigned char*)d_ws;
#if MK_COOP
    a.ph_lo = 0; a.ph_hi = N_PHASES;
    void* kargs[] = {&a};
    hipError_t e = hipLaunchCooperativeKernel((const void*)fwd_kernel, dim3(grid), dim3(NWAVES * 64), kargs, LDS_BYTES, stream);
    if (e != hipSuccess) fprintf(stderr, "cooperative launch failed: %s (grid %d)\n", hipGetErrorString(e), grid);
#else
    for (int p = 0; p < N_PHASES; ++p) { a.ph_lo = p; a.ph_hi = p + 1; hipLaunchKernelGGL(fwd_kernel, dim3(grid), dim3(NWAVES * 64), LDS_BYTES, stream, a); }
#endif
}
```

```cpp
#include <hip/hip_runtime.h>
#include <cstdio>
#include <cstdint>
#include <hip/hip_cooperative_groups.h>
namespace pg8 {
#define PG8_LAS __attribute__((address_space(3)))
typedef unsigned short bf16_t;
typedef short bf16x8 __attribute__((ext_vector_type(8)));
typedef float f32x4 __attribute__((ext_vector_type(4)));
typedef unsigned u32x4 __attribute__((ext_vector_type(4)));
constexpr int BM = 256, BK = 64, HALF = 128, HTB = HALF * BK * 2  , STAGE_BYTES = 8 * HTB, NXCD = 8, WGM = 8;

__host__ __device__ __forceinline__ int lds_byte(int r, int c) { const int st = (r >> 4) * 2 + (c >> 5), rr = r & 15, cc = c & 31, ob = rr * 64 + cc * 2; return st * 1024 + (ob ^ (((ob >> 9) & 1) << 5)); }
__host__ __device__ __forceinline__ void stage_rc(int b, int& R, int& C) { const int st = b / 1024, sb = b % 1024, swz = sb ^ (((sb >> 9) & 1) << 5); R = (st >> 1) * 16 + swz / 64; C = (st & 1) * 32 + (swz % 64) / 2; }
__host__ __device__ __forceinline__ int perm32(int rho) { const int n = rho >> 4, i = rho & 15; return 8 * (i >> 2) + 4 * n + (i & 3); }

template <class E, class = void> struct epi_wants_sched { static constexpr bool value = false; };
template <class E> struct epi_wants_sched<E, decltype((void)E::SCHED)> { static constexpr bool value = true; };
struct Unit { int pm, pn; };
struct Gemm { const bf16_t* A; const bf16_t* Bt; int M, N, K; };

struct StaticOrder {
    int nM, nN, nwg, G, c;
    __host__ __device__ void init(int M, int N, int G_, int c_) { nM = M / BM; nN = N / BM; nwg = nM * nN; G = G_; c = c_; }
    __host__ __device__ bool next(int i, Unit& u) const {
        const long L = (long)i * G + c; if (L >= nwg) return false;
        int wgid = (int)L; { const int q = nwg / NXCD, r = nwg % NXCD, xcd = wgid % NXCD, off = wgid / NXCD; wgid = (xcd < r ? xcd * (q + 1) : r * (q + 1) + (xcd - r) * q) + off; }
        const int nig = WGM * nN, gid = wgid / nig, fm = gid * WGM, gsz = (nM - fm) < WGM ? (nM - fm) : WGM;
        u.pm = fm + ((wgid % nig) % gsz); u.pn = (wgid % nig) / gsz; return true;
    }
    __device__ __forceinline__ void a_ready(const Unit&) const {}
    __device__ __forceinline__ void done(const Unit&) const {}
    __host__ __device__ __forceinline__ int arow(const Unit& u) const { return u.pm * BM; }
};
struct HaloOrder : StaticOrder {
    static constexpr int SEQR = 8192, NT_ = 33;
    __host__ __device__ void init(int nseq, int N, int G_, int c_) { nM = nseq * NT_; nN = N / BM; nwg = nM * nN; G = G_; c = c_; }
    __host__ __device__ __forceinline__ int arow(const Unit& u) const { const int b = u.pm / NT_, j = u.pm % NT_; const int st = 254 * j; return b * SEQR + (st < SEQR - 256 ? st : SEQR - 256); }
    __host__ __device__ __forceinline__ int rlo(const Unit& u) const { const int j = u.pm % NT_; return j == 0 ? 0 : (j < NT_ - 1 ? 2 : (254 * (NT_ - 2) + 256) - (SEQR - 256)); }
};

__device__ __forceinline__ unsigned cvt_pk_bf16(float lo, float hi) { unsigned r; asm volatile("v_cvt_pk_bf16_f32 %0, %1, %2" : "=v"(r) : "v"(lo), "v"(hi)); return r; }
typedef float f32x2 __attribute__((ext_vector_type(2)));
__device__ __forceinline__ f32x2 gelu_pk(f32x2 v) {
    const f32x2 av = __builtin_elementwise_abs(v), d = av * 0.2316418882f + 1.0f;
    f32x2 t; t.x = __builtin_amdgcn_rcpf(d.x); t.y = __builtin_amdgcn_rcpf(d.y);
    f32x2 q = t * 0.5307027145f + (-0.7265760135f); q = q * t + 0.7107068705f; q = q * t + (-0.142248368f); q = q * t + 0.127414796f; q = q * t;
    const f32x2 s = (v * v) * (-0.72134752044f);
    f32x2 e; e.x = __builtin_amdgcn_exp2f(s.x); e.y = __builtin_amdgcn_exp2f(s.y);
    const f32x2 m = v * (q * e), r = v - m;
    f32x2 o; o.x = v.x < 0.f ? m.x : r.x; o.y = v.y < 0.f ? m.y : r.y; return o;
}

template <int ACT  > struct EpiBf16 {
    static constexpr bool PERM = true, AFTER_DRAIN = false, MID = false; static_assert(ACT == 0 || ACT == 1, "EpiBf16: ACT is 0 (none) or 1 (gelu_pk)");
    bf16_t* O; int ldc; const float* bias; int split_cols; size_t split_stride; float scale0;
    __device__ __forceinline__ void operator()(const f32x4 (&acc)[2][2][4][2], const Unit& u, int wr, int wc, int fr, int fq) const {
        const int row0 = u.pm * BM + wr * 64 + fr; int colt = u.pn * BM; bf16_t* base = O;
        float sc = 1.f; if (split_cols) { const int t = colt / split_cols; base += (size_t)t * split_stride; colt -= t * split_cols; if (t == 0) sc = scale0; }
        const int col0 = colt + wc * 32 + 8 * fq, bcol0 = u.pn * BM + wc * 32 + 8 * fq;
        f32x4 bv[2][2];
#pragma unroll
        for (int bj = 0; bj < 2; ++bj)
#pragma unroll
            for (int n = 0; n < 2; ++n) bv[bj][n] = bias ? *(const f32x4*)(bias + bcol0 + bj * HALF + 4 * n) : (f32x4){0.f, 0.f, 0.f, 0.f};
#pragma unroll
        for (int ai = 0; ai < 2; ++ai)
#pragma unroll
            for (int m = 0; m < 4; ++m) { bf16_t* rowp = base + (size_t)(row0 + ai * HALF + m * 16) * ldc + col0;
#pragma unroll
                for (int bj = 0; bj < 2; ++bj) { f32x4 v0 = acc[ai][bj][m][0] + bv[bj][0], v1 = acc[ai][bj][m][1] + bv[bj][1];
                    if (ACT == 1) { f32x2 a = gelu_pk((f32x2){v0[0], v0[1]}), b = gelu_pk((f32x2){v0[2], v0[3]}), c = gelu_pk((f32x2){v1[0], v1[1]}), d = gelu_pk((f32x2){v1[2], v1[3]});
                        v0 = (f32x4){a.x, a.y, b.x, b.y}; v1 = (f32x4){c.x, c.y, d.x, d.y}; }
                    v0 = v0 * sc; v1 = v1 * sc; u32x4 w; w.x = cvt_pk_bf16(v0[0], v0[1]); w.y = cvt_pk_bf16(v0[2], v0[3]); w.z = cvt_pk_bf16(v1[0], v1[1]); w.w = cvt_pk_bf16(v1[2], v1[3]);
                    *(u32x4*)(rowp + bj * HALF) = w; } }
    }
};
__device__ __forceinline__ float bf_lo(unsigned w) { return __uint_as_float(w << 16); }
__device__ __forceinline__ float bf_hi(unsigned w) { return __uint_as_float(w & 0xffff0000u); }
__device__ __forceinline__ float sigmoidf_(float x) { return __builtin_amdgcn_rcpf(1.0f + __expf(-x)); }
struct EpiIn {
    static constexpr bool PERM = true, AFTER_DRAIN = false, MID = false;
    bf16_t* CB; size_t st16, offGA, st32; const float* qg; long kdelta; float c2, eps;
    __device__ __forceinline__ void operator()(const f32x4 (&acc)[2][2][4][2], const Unit& u, int wr, int wc, int fr, int fq) const {
        const int pn = u.pn, row0 = u.pm * BM + wr * 64 + fr;
        if (pn >= 6 && pn < 10) {
            const bool isq = pn < 8; bf16_t* base = CB + (size_t)(pn >> 1) * st16; const float* g = qg + (isq ? 0L : kdelta); const float sc = isq ? c2 : 1.f;
            const int hcol = ((pn & 1) * 4 + wc) * 64;
            f32x4 gv[2][2];
#pragma unroll
            for (int bj = 0; bj < 2; ++bj)
#pragma unroll
                for (int n = 0; n < 2; ++n) gv[bj][n] = *(const f32x4*)(g + 32 * bj + 8 * fq + 4 * n);
#pragma unroll
            for (int ai = 0; ai < 2; ++ai)
#pragma unroll
                for (int m = 0; m < 4; ++m) {
                    float ss = 0.f;
#pragma unroll
                    for (int bj = 0; bj < 2; ++bj)
#pragma unroll
                        for (int n = 0; n < 2; ++n) { const f32x4 x = acc[ai][bj][m][n]; ss += (x[0] * x[0] + x[1] * x[1]) + (x[2] * x[2] + x[3] * x[3]); }
                    ss += __shfl_xor(ss, 16); ss += __shfl_xor(ss, 32);
                    const float inv = __builtin_amdgcn_rsqf(ss * (1.0f / 64.0f) + eps) * sc;
                    bf16_t* rowp = base + (size_t)(row0 + ai * HALF + m * 16) * 512 + hcol + 8 * fq;
#pragma unroll
                    for (int bj = 0; bj < 2; ++bj) { const f32x4 v0 = acc[ai][bj][m][0] * inv * gv[bj][0], v1 = acc[ai][bj][m][1] * inv * gv[bj][1];
                        u32x4 w; w.x = cvt_pk_bf16(v0[0], v0[1]); w.y = cvt_pk_bf16(v0[2], v0[3]); w.z = cvt_pk_bf16(v1[0], v1[1]); w.w = cvt_pk_bf16(v1[2], v1[3]);
                        *(u32x4*)(rowp + 32 * bj) = w; }
                }
        } else {
            bf16_t* base; int ldc, colt; bool sig = false;
            if (pn < 12) { base = CB + (size_t)(pn >> 1) * st16; ldc = 512; colt = (pn & 1) * 256; }
            else { base = CB + offGA + (size_t)((pn - 12) >> 2) * st32; ldc = 1024; colt = ((pn - 12) & 3) * 256; sig = true; }
            const int col0 = colt + wc * 32 + 8 * fq;
#pragma unroll
            for (int ai = 0; ai < 2; ++ai)
#pragma unroll
                for (int m = 0; m < 4; ++m) { bf16_t* rowp = base + (size_t)(row0 + ai * HALF + m * 16) * ldc + col0;
#pragma unroll
                    for (int bj = 0; bj < 2; ++bj) { f32x4 v0 = acc[ai][bj][m][0], v1 = acc[ai][bj][m][1];
                        if (sig) { v0 = (f32x4){sigmoidf_(v0[0]), sigmoidf_(v0[1]), sigmoidf_(v0[2]), sigmoidf_(v0[3])}; v1 = (f32x4){sigmoidf_(v1[0]), sigmoidf_(v1[1]), sigmoidf_(v1[2]), sigmoidf_(v1[3])}; }
                        u32x4 w; w.x = cvt_pk_bf16(v0[0], v0[1]); w.y = cvt_pk_bf16(v0[2], v0[3]); w.z = cvt_pk_bf16(v1[0], v1[1]); w.w = cvt_pk_bf16(v1[2], v1[3]);
                        *(u32x4*)(rowp + bj * HALF) = w; } }
        }
    }
};
struct EpiMerged {
    static constexpr bool PERM = true, AFTER_DRAIN = false, MID = true;
    const bf16_t *GA, *GB; bf16_t* O;
    __device__ __forceinline__ void mid(f32x4 (&acc)[2][2][4][2], const Unit& u, int wr, int wc, int fr, int fq) const {
        int row0 = u.pm * BM + wr * 64 + fr, col0 = u.pn * BM + wc * 32 + 8 * fq;
        asm volatile("" : "+v"(row0), "+v"(col0));
#pragma unroll
        for (int ai = 0; ai < 2; ++ai)
#pragma unroll
            for (int m = 0; m < 4; ++m) { const size_t off = (size_t)(row0 + ai * HALF + m * 16) * 1024 + col0;
#pragma unroll
                for (int bj = 0; bj < 2; ++bj) { const u32x4 a = *(const u32x4*)(GA + off + bj * HALF), b = *(const u32x4*)(GB + off + bj * HALF);
                    f32x4 r0, r1;
                    r0[0] = bf_lo(a.x) * __builtin_amdgcn_rcpf(bf_lo(b.x)); r0[1] = bf_hi(a.x) * __builtin_amdgcn_rcpf(bf_hi(b.x));
                    r0[2] = bf_lo(a.y) * __builtin_amdgcn_rcpf(bf_lo(b.y)); r0[3] = bf_hi(a.y) * __builtin_amdgcn_rcpf(bf_hi(b.y));
                    r1[0] = bf_lo(a.z) * __builtin_amdgcn_rcpf(bf_lo(b.z)); r1[1] = bf_hi(a.z) * __builtin_amdgcn_rcpf(bf_hi(b.z));
                    r1[2] = bf_lo(a.w) * __builtin_amdgcn_rcpf(bf_lo(b.w)); r1[3] = bf_hi(a.w) * __builtin_amdgcn_rcpf(bf_hi(b.w));
                    acc[ai][bj][m][0] *= r0; acc[ai][bj][m][1] *= r1; asm volatile("" ::: "memory"); } }
    }
    __device__ __forceinline__ void operator()(const f32x4 (&acc)[2][2][4][2], const Unit& u, int wr, int wc, int fr, int fq) const {
        const int row0 = u.pm * BM + wr * 64 + fr, col0 = u.pn * BM + wc * 32 + 8 * fq;
#pragma unroll
        for (int ai = 0; ai < 2; ++ai)
#pragma unroll
            for (int m = 0; m < 4; ++m) { const size_t off = (size_t)(row0 + ai * HALF + m * 16) * 1024 + col0;
#pragma unroll
                for (int bj = 0; bj < 2; ++bj) { const u32x4 b = *(const u32x4*)(GB + off + bj * HALF);
                    const f32x4 v0 = acc[ai][bj][m][0] * (f32x4){bf_lo(b.x), bf_hi(b.x), bf_lo(b.y), bf_hi(b.y)}, v1 = acc[ai][bj][m][1] * (f32x4){bf_lo(b.z), bf_hi(b.z), bf_lo(b.w), bf_hi(b.w)};
                    u32x4 w; w.x = cvt_pk_bf16(v0[0], v0[1]); w.y = cvt_pk_bf16(v0[2], v0[3]); w.z = cvt_pk_bf16(v1[0], v1[1]); w.w = cvt_pk_bf16(v1[2], v1[3]);
                    *(u32x4*)(O + off + bj * HALF) = w; asm volatile("" ::: "memory"); } }
    }
};
template <bool NORM> struct EpiRes {
    static constexpr bool PERM = true, AFTER_DRAIN = false, MID = false;
    const float* base; float* out; const float* gacc; const float* gbias; int rows_per_batch, gstride;
    bf16_t* xn; const float* ng; const float* scacc; const float* scbias; float* ssq; bf16_t* x1b;
    __device__ __forceinline__ void operator()(const f32x4 (&acc)[2][2][4][2], const Unit& u, int wr, int wc, int fr, int fq) const {
        const int b = (u.pm * BM) / rows_per_batch, row0 = u.pm * BM + wr * 64 + fr, col0 = u.pn * BM + wc * 32 + 8 * fq;
        f32x4 gv[2][2], av[2][2];
#pragma unroll
        for (int bj = 0; bj < 2; ++bj)
#pragma unroll
            for (int n = 0; n < 2; ++n) { const int c = col0 + bj * HALF + n * 4;
                gv[bj][n] = *(const f32x4*)(gacc + (size_t)b * gstride + c) + *(const f32x4*)(gbias + c);
                if (NORM) av[bj][n] = *(const f32x4*)(ng + c) * (*(const f32x4*)(scacc + (size_t)b * gstride + c) + *(const f32x4*)(scbias + c) + 1.0f); }
#pragma unroll
        for (int ai = 0; ai < 2; ++ai)
#pragma unroll
            for (int m = 0; m < 4; ++m) { const int row = row0 + ai * HALF + m * 16; const size_t off = (size_t)row * 1024 + col0; float ss = 0.f;
#pragma unroll
                for (int bj = 0; bj < 2; ++bj) { f32x4 o[2];
                    if constexpr (NORM) {
#pragma unroll
                        for (int n = 0; n < 2; ++n) { const f32x4 bs = __builtin_nontemporal_load((const f32x4*)(base + off + bj * HALF + n * 4)); o[n] = bs + gv[bj][n] * acc[ai][bj][m][n]; }
                        u32x4 xw; xw.x = cvt_pk_bf16(o[0][0], o[0][1]); xw.y = cvt_pk_bf16(o[0][2], o[0][3]); xw.z = cvt_pk_bf16(o[1][0], o[1][1]); xw.w = cvt_pk_bf16(o[1][2], o[1][3]);
                        *(u32x4*)(x1b + off + bj * HALF) = xw;
                    } else {
                        const u32x4 xb = __builtin_nontemporal_load((const u32x4*)(x1b + off + bj * HALF));
                        o[0] = (f32x4){bf_lo(xb.x), bf_hi(xb.x), bf_lo(xb.y), bf_hi(xb.y)} + gv[bj][0] * acc[ai][bj][m][0]; o[1] = (f32x4){bf_lo(xb.z), bf_hi(xb.z), bf_lo(xb.w), bf_hi(xb.w)} + gv[bj][1] * acc[ai][bj][m][1];
#pragma unroll
                        for (int n = 0; n < 2; ++n) __builtin_nontemporal_store(o[n], (f32x4*)(out + off + bj * HALF + n * 4));
                    }
                    if (NORM) { ss += (o[0][0] * o[0][0] + o[0][1] * o[0][1]) + (o[0][2] * o[0][2] + o[0][3] * o[0][3]) + (o[1][0] * o[1][0] + o[1][1] * o[1][1]) + (o[1][2] * o[1][2] + o[1][3] * o[1][3]);
                        const f32x4 h0 = o[0] * av[bj][0], h1 = o[1] * av[bj][1];
                        u32x4 w; w.x = cvt_pk_bf16(h0[0], h0[1]); w.y = cvt_pk_bf16(h0[2], h0[3]); w.z = cvt_pk_bf16(h1[0], h1[1]); w.w = cvt_pk_bf16(h1[2], h1[3]);
                        *(u32x4*)(xn + off + bj * HALF) = w; } }
                if (NORM) { ss += __shfl_xor(ss, 16); ss += __shfl_xor(ss, 32); if (fq == 0) atomicAdd(ssq + row, ss); }
                if (m & 1) asm volatile("" ::: "memory"); }
    }
};
__device__ __forceinline__ float dpp_ror1(float x) { return __builtin_bit_cast(float, __builtin_amdgcn_update_dpp(0, __builtin_bit_cast(int, x), 0x121, 0xf, 0xf, false)); }
__device__ __forceinline__ float dpp_ror2(float x) { return __builtin_bit_cast(float, __builtin_amdgcn_update_dpp(0, __builtin_bit_cast(int, x), 0x122, 0xf, 0xf, false)); }
struct EpiUpConv {
    static constexpr bool PERM = true, AFTER_DRAIN = false, MID = false, SCHED = true;
    bf16_t* ACT; const float* ssq; const float* cvec; const float* cw; PG8_LAS float* ex; float invk, eps; int dff, nup, rows_per_batch;
    template <class Sched> __device__ __forceinline__ void run(f32x4 (&acc)[2][2][4][2], const Unit& u, const Sched& S, int wr, int wc, int fr, int fq) const {
        const int arow = S.arow(u), rlo = S.rlo(u), b = arow / rows_per_batch, wid = wr * 4 + wc;
        const int slot0 = u.pn * BM + wc * 32 + 8 * fq, ch0 = u.pn * HALF + wc * 32 + 8 * fq;
        { f32x4 cv[2][2];
#pragma unroll
          for (int bj = 0; bj < 2; ++bj)
#pragma unroll
              for (int n = 0; n < 2; ++n) cv[bj][n] = *(const f32x4*)(cvec + (size_t)b * nup + slot0 + bj * HALF + n * 4);
#pragma unroll
          for (int ai = 0; ai < 2; ++ai)
#pragma unroll
              for (int m = 0; m < 4; ++m) { const float inv = __builtin_amdgcn_rsqf(ssq[arow + ai * HALF + wr * 64 + m * 16 + fr] * invk + eps);
#pragma unroll
                  for (int bj = 0; bj < 2; ++bj)
#pragma unroll
                      for (int n = 0; n < 2; ++n) acc[ai][bj][m][n] = acc[ai][bj][m][n] * inv + cv[bj][n]; } }
        if (fr >= 14) {
#pragma unroll
            for (int ai = 0; ai < 2; ++ai) { PG8_LAS f32x4* d = (PG8_LAS f32x4*)(ex + ((((wid * 2 + ai) * 2 + (fr - 14)) * 4 + fq) * 16));
                d[0] = acc[ai][0][3][0]; d[1] = acc[ai][0][3][1]; d[2] = acc[ai][1][3][0]; d[3] = acc[ai][1][3][1]; }
        }
        asm volatile("s_waitcnt lgkmcnt(0)" ::: "memory"); __builtin_amdgcn_s_barrier(); asm volatile("" ::: "memory");
        typedef unsigned u32x2 __attribute__((ext_vector_type(2)));
#pragma unroll
        for (int n = 0; n < 2; ++n) {
            f32x4 w[3][2];
#pragma unroll
            for (int k = 0; k < 3; ++k)
#pragma unroll
                for (int bj = 0; bj < 2; ++bj) w[k][bj] = *(const f32x4*)(cw + (size_t)k * nup + bj * dff + ch0 + n * 4);
#pragma unroll
            for (int ai = 0; ai < 2; ++ai) {
                f32x4 p1[2], p2[2];
                if (wr == 1 || ai == 1) { const int sw = wr == 1 ? wid - 4 : wid + 4, sa = wr == 1 ? ai : 0;
                    const PG8_LAS f32x4* e1 = (const PG8_LAS f32x4*)(ex + ((((sw * 2 + sa) * 2 + 1) * 4 + fq) * 16)); const PG8_LAS f32x4* e2 = (const PG8_LAS f32x4*)(ex + ((((sw * 2 + sa) * 2 + 0) * 4 + fq) * 16));
#pragma unroll
                    for (int bj = 0; bj < 2; ++bj) { const f32x4 r1 = e1[bj * 2 + n], r2 = e2[bj * 2 + n]; p1[bj] = r1; p2[bj] = fr == 0 ? r2 : r1; }
                } else {
#pragma unroll
                    for (int bj = 0; bj < 2; ++bj) { p1[bj] = (f32x4){0.f, 0.f, 0.f, 0.f}; p2[bj] = (f32x4){0.f, 0.f, 0.f, 0.f}; }
                }
#pragma unroll
                for (int m = 0; m < 4; ++m) {
                    f32x4 cvv[2];
#pragma unroll
                    for (int bj = 0; bj < 2; ++bj) { const f32x4 x = acc[ai][bj][m][n]; f32x4 t1, t2, q1, q2;
#pragma unroll
                        for (int i = 0; i < 4; ++i) { t1[i] = dpp_ror1(x[i]); t2[i] = dpp_ror2(x[i]); q1[i] = fr >= 1 ? t1[i] : p1[bj][i]; q2[i] = fr >= 2 ? t2[i] : p2[bj][i]; }
                        cvv[bj] = w[0][bj] * q2 + w[1][bj] * q1 + w[2][bj] * x;
                        p1[bj] = t1; p2[bj] = t2; }
                    const int lr = ai * HALF + wr * 64 + m * 16 + fr;
                    f32x4 o;
#pragma unroll
                    for (int i = 0; i < 4; ++i) { const float g0 = cvv[0][i]; o[i] = g0 * __builtin_amdgcn_rcpf(1.0f + __expf(-g0)) * cvv[1][i]; }
                    if (lr >= rlo) { u32x2 wv; wv.x = cvt_pk_bf16(o[0], o[1]); wv.y = cvt_pk_bf16(o[2], o[3]); *(u32x2*)(ACT + (size_t)(arow + lr) * dff + ch0 + n * 4) = wv; }
                }
            }
        }
    }
};
struct EpiUp {
    static constexpr bool PERM = true, AFTER_DRAIN = false, MID = false;
    bf16_t* O; int ldc; const float* ssq; const float* cvec; float invk, eps;
    __device__ __forceinline__ void operator()(const f32x4 (&acc)[2][2][4][2], const Unit& u, int wr, int wc, int fr, int fq) const {
        const int row0 = u.pm * BM + wr * 64 + fr, col0 = u.pn * BM + wc * 32 + 8 * fq;
        f32x4 cv[2][2];
#pragma unroll
        for (int bj = 0; bj < 2; ++bj)
#pragma unroll
            for (int n = 0; n < 2; ++n) cv[bj][n] = *(const f32x4*)(cvec + col0 + bj * HALF + n * 4);
#pragma unroll
        for (int ai = 0; ai < 2; ++ai)
#pragma unroll
            for (int m = 0; m < 4; ++m) { const int row = row0 + ai * HALF + m * 16; const float inv = __builtin_amdgcn_rsqf(ssq[row] * invk + eps);
                bf16_t* rowp = O + (size_t)row * ldc + col0;
#pragma unroll
                for (int bj = 0; bj < 2; ++bj) { const f32x4 v0 = acc[ai][bj][m][0] * inv + cv[bj][0], v1 = acc[ai][bj][m][1] * inv + cv[bj][1];
                    u32x4 w; w.x = cvt_pk_bf16(v0[0], v0[1]); w.y = cvt_pk_bf16(v0[2], v0[3]); w.z = cvt_pk_bf16(v1[0], v1[1]); w.w = cvt_pk_bf16(v1[2], v1[3]);
                    *(u32x4*)(rowp + bj * HALF) = w; } }
    }
};
template <class Epi, class Sched, bool ALIGN_EPI = false, bool SP2 = false>
__device__ __forceinline__ void gemm_phase(PG8_LAS unsigned char* lds, const Gemm g, const Sched& S, const Epi& E) {
    const int tid = threadIdx.x, wid = __builtin_amdgcn_readfirstlane(tid >> 6), lane = tid & 63, wr = wid >> 2, wc = wid & 3, fr = lane & 15, fq = lane >> 4;
    const int K = g.K, nt = K / BK;
    unsigned voffA[2], voffB[2];
#pragma unroll
    for (int i = 0; i < 2; ++i) { int R, C; stage_rc(tid * 16 + i * 8192, R, C); const int Rb = Epi::PERM ? ((R & ~31) + perm32(R & 31)) : R;
        voffA[i] = (unsigned)(R * K + C) * 2u; voffB[i] = (unsigned)(Rb * K + C) * 2u; }
    const size_t kstep = (size_t)(BK * 2);
    const size_t hstep = (size_t)HALF * K * 2;
    const size_t tstep = 2 * hstep;
    const unsigned ldsw = (unsigned)wid * 1024u;
    const int aoff = lds_byte(wr * 64 + fr, fq * 8), boff = lds_byte(wc * 32 + fr, fq * 8);
#define PG8_SA(b, h) (((b) * 2 + (h)) * HTB)
#define PG8_SB(b, h) ((4 + (b) * 2 + (h)) * HTB)
#define PG8_STAGE(bufoff, gbase, voff) do { _Pragma("unroll") for (int _i = 0; _i < 2; ++_i) \
        __builtin_amdgcn_global_load_lds((const unsigned*)((const char*)(gbase) + (voff)[_i]), (PG8_LAS unsigned*)(lds + (bufoff) + ldsw + _i * 8192), 16, 0, 0); } while (0)
#define PG8_LDA(dst, b, h) do { _Pragma("unroll") for (int m = 0; m < 4; ++m) _Pragma("unroll") for (int k = 0; k < 2; ++k) dst[m][k] = *(const PG8_LAS bf16x8*)(lds + PG8_SA(b, h) + aoff + m * 2048 + k * 1024); } while (0)
#define PG8_LDB(dst, b, h) do { _Pragma("unroll") for (int n = 0; n < 2; ++n) _Pragma("unroll") for (int k = 0; k < 2; ++k) dst[n][k] = *(const PG8_LAS bf16x8*)(lds + PG8_SB(b, h) + boff + n * 2048 + k * 1024); } while (0)
#define PG8_MMA(ai, bj, At, Bt) do { __builtin_amdgcn_s_setprio(1); _Pragma("unroll") for (int m = 0; m < 4; ++m) _Pragma("unroll") for (int n = 0; n < 2; ++n) _Pragma("unroll") for (int k = 0; k < 2; ++k) \
        acc[ai][bj][m][n] = __builtin_amdgcn_mfma_f32_16x16x32_bf16(Bt[n][k], At[m][k], acc[ai][bj][m][n], 0, 0, 0); __builtin_amdgcn_s_setprio(0); } while (0)
#define PG8_WAIT_V(n) asm volatile("s_waitcnt vmcnt(" #n ")" ::: "memory")
#define PG8_WAIT_L(n) asm volatile("s_waitcnt lgkmcnt(" #n ")" ::: "memory")
#define PG8_BAR __builtin_amdgcn_s_barrier()
#define PG8_SCHED __builtin_amdgcn_sched_barrier(0)
    Unit cur, nxt; int ui = 0;
    if (!S.next(0, cur)) return;
    f32x4 acc[2][2][4][2];
#pragma unroll
    for (int a = 0; a < 2; ++a)
#pragma unroll
        for (int b = 0; b < 2; ++b)
#pragma unroll
            for (int m = 0; m < 4; ++m)
#pragma unroll
                for (int n = 0; n < 2; ++n) acc[a][b][m][n] = (f32x4){0.f, 0.f, 0.f, 0.f};
    bf16x8 At[4][2], B0[2][2], B1[2][2];
    const size_t rstep = (size_t)K * 2;
    const char* cA = (const char*)g.A + (size_t)S.arow(cur) * rstep; const char* cB = (const char*)g.Bt + (size_t)cur.pn * tstep;
    S.a_ready(cur);
    if constexpr (SP2) {
        PG8_STAGE(PG8_SB(0, 0), cB, voffB); PG8_STAGE(PG8_SB(0, 1), cB + hstep, voffB); PG8_STAGE(PG8_SA(0, 0), cA, voffA); PG8_STAGE(PG8_SA(0, 1), cA + hstep, voffA);
        if (wr == 1) PG8_BAR;
        PG8_WAIT_V(2); PG8_BAR;
        PG8_STAGE(PG8_SB(1, 0), cB + kstep, voffB); PG8_STAGE(PG8_SA(1, 0), cA + kstep, voffA); PG8_STAGE(PG8_SB(1, 1), cB + hstep + kstep, voffB);
        PG8_WAIT_V(6); PG8_BAR;
    } else {
        PG8_STAGE(PG8_SB(0, 0), cB, voffB); PG8_STAGE(PG8_SA(0, 0), cA, voffA); PG8_STAGE(PG8_SB(0, 1), cB + hstep, voffB); PG8_STAGE(PG8_SA(0, 1), cA + hstep, voffA);
        if (wr == 1) PG8_BAR;
        PG8_WAIT_V(4); PG8_BAR;
        PG8_STAGE(PG8_SB(1, 0), cB + kstep, voffB); PG8_STAGE(PG8_SA(1, 0), cA + kstep, voffA); PG8_STAGE(PG8_SB(1, 1), cB + hstep + kstep, voffB);
        PG8_WAIT_V(6); PG8_BAR;
    }
    for (;;) {
        const bool has_next = S.next(ui + 1, nxt);
        const char* nA = has_next ? (const char*)g.A + (size_t)S.arow(nxt) * rstep : cA; const char* nB = has_next ? (const char*)g.Bt + (size_t)nxt.pn * tstep : cB;
        for (int t = 0; t < nt; t += 2) {
            const bool last = (t == nt - 2);
            if constexpr (Epi::MID) { if (t == (nt >> 1)) E.mid(acc, cur, wr, wc, fr, fq); }
            const char* a1 = cA + (size_t)(t + 1) * kstep;
            const char* a2 = last ? nA : cA + (size_t)(t + 2) * kstep; const char* b2 = last ? nB : cB + (size_t)(t + 2) * kstep;
            const char* a3 = a2 + kstep; const char* b3 = b2 + kstep;
            if (last && has_next) S.a_ready(nxt);
            if constexpr (SP2) {
            PG8_LDB(B0, 0, 0); PG8_LDB(B1, 0, 1); PG8_SCHED; PG8_LDA(At, 0, 0); PG8_STAGE(PG8_SA(1, 1), a1 + hstep, voffA);
            PG8_WAIT_V(8); PG8_WAIT_L(0); PG8_BAR; PG8_MMA(0, 0, At, B0); PG8_MMA(0, 1, At, B1); PG8_BAR; PG8_SCHED;
            PG8_LDA(At, 0, 1); PG8_STAGE(PG8_SB(0, 0), b2, voffB); PG8_STAGE(PG8_SB(0, 1), b2 + hstep, voffB); PG8_STAGE(PG8_SA(0, 0), a2, voffA);
            PG8_WAIT_V(8); PG8_WAIT_L(0); PG8_BAR; PG8_MMA(1, 0, At, B0); PG8_MMA(1, 1, At, B1); PG8_BAR; PG8_SCHED;
            PG8_LDB(B0, 1, 0); PG8_LDB(B1, 1, 1); PG8_SCHED; PG8_LDA(At, 1, 0); PG8_STAGE(PG8_SA(0, 1), a2 + hstep, voffA);
            PG8_WAIT_V(8); PG8_WAIT_L(0); PG8_BAR; PG8_MMA(0, 0, At, B0); PG8_MMA(0, 1, At, B1); PG8_BAR; PG8_SCHED;
            PG8_LDA(At, 1, 1); PG8_STAGE(PG8_SB(1, 0), b3, voffB); PG8_STAGE(PG8_SB(1, 1), b3 + hstep, voffB); PG8_STAGE(PG8_SA(1, 0), a3, voffA);
            PG8_WAIT_V(8); PG8_WAIT_L(0); PG8_BAR; PG8_MMA(1, 0, At, B0); PG8_MMA(1, 1, At, B1); PG8_BAR; PG8_SCHED;
            } else {
            PG8_LDB(B0, 0, 0); PG8_SCHED; PG8_LDA(At, 0, 0); PG8_STAGE(PG8_SA(1, 1), a1 + hstep, voffA);
            PG8_WAIT_L(8); PG8_BAR; PG8_WAIT_L(0); PG8_MMA(0, 0, At, B0); PG8_BAR; PG8_SCHED;
            PG8_LDB(B1, 0, 1); PG8_STAGE(PG8_SB(0, 0), b2, voffB);
            PG8_BAR; PG8_WAIT_L(0); PG8_MMA(0, 1, At, B1); PG8_BAR;
            PG8_LDA(At, 0, 1); PG8_STAGE(PG8_SA(0, 0), a2, voffA);
            PG8_BAR; PG8_WAIT_L(0); PG8_MMA(1, 0, At, B0); PG8_BAR; PG8_SCHED;
            PG8_STAGE(PG8_SB(0, 1), b2 + hstep, voffB);
            PG8_WAIT_V(6); PG8_BAR; PG8_MMA(1, 1, At, B1); PG8_BAR;
            PG8_LDB(B0, 1, 0); PG8_SCHED; PG8_LDA(At, 1, 0); PG8_STAGE(PG8_SA(0, 1), a2 + hstep, voffA);
            PG8_WAIT_L(8); PG8_BAR; PG8_WAIT_L(0); PG8_MMA(0, 0, At, B0); PG8_BAR; PG8_SCHED;
            PG8_LDB(B1, 1, 1); PG8_STAGE(PG8_SB(1, 0), b3, voffB);
            PG8_BAR; PG8_WAIT_L(0); PG8_MMA(0, 1, At, B1); PG8_BAR;
            PG8_LDA(At, 1, 1); PG8_STAGE(PG8_SA(1, 0), a3, voffA);
            PG8_BAR; PG8_WAIT_L(0); PG8_MMA(1, 0, At, B0); PG8_BAR; PG8_SCHED;
            PG8_STAGE(PG8_SB(1, 1), b3 + hstep, voffB);
            PG8_WAIT_V(6); PG8_BAR; PG8_MMA(1, 1, At, B1); PG8_BAR;
            }
        }
        if constexpr (ALIGN_EPI) { if (wr == 0) PG8_BAR; }
        if constexpr (!Epi::AFTER_DRAIN) { if constexpr (epi_wants_sched<Epi>::value) E.run(acc, cur, S, wr, wc, fr, fq); else E(acc, cur, wr, wc, fr, fq); S.done(cur); }
        if (!has_next) break;
#pragma unroll
        for (int a = 0; a < 2; ++a)
#pragma unroll
            for (int b = 0; b < 2; ++b)
#pragma unroll
                for (int m = 0; m < 4; ++m)
#pragma unroll
                    for (int n = 0; n < 2; ++n) acc[a][b][m][n] = (f32x4){0.f, 0.f, 0.f, 0.f};
        cur = nxt; cA = nA; cB = nB; ++ui;
        if constexpr (ALIGN_EPI) { if (wr == 1) PG8_BAR; }
    }
    PG8_WAIT_V(0);
    if constexpr (!ALIGN_EPI) { if (wr == 0) PG8_BAR; }
    PG8_BAR;
    if constexpr (Epi::AFTER_DRAIN) { E.fused(acc, cur, wr, wc, fr, fq, lds, wid, lane); S.done(cur); }
#undef PG8_SA
#undef PG8_SB
#undef PG8_STAGE
#undef PG8_LDA
#undef PG8_LDB
#undef PG8_MMA
#undef PG8_WAIT_V
#undef PG8_WAIT_L
#undef PG8_BAR
#undef PG8_SCHED
}
}

#ifndef PG8_SP2
#define PG8_SP2 true
#endif
#ifndef PG8_ALIGN
#define PG8_ALIGN true
#endif
#include <hip/hip_bf16.h>
#include <cmath>
namespace attn_body {
using bf16=__hip_bfloat16;
using bf16x8=__attribute__((ext_vector_type(8)))short;
using s16x4=__attribute__((ext_vector_type(4)))short;
using f32x16=__attribute__((ext_vector_type(16)))float;
using u32x4=__attribute__((ext_vector_type(4)))unsigned;
constexpr int BATCH=2,NHEAD=8,SEQ=8192,D=64,DM=NHEAD*D,OPITCH=1024;
constexpr int NW=8,QBLK=32,QB=QBLK*NW,KVBLK=64,NQB=SEQ/QB;
constexpr int ATTN_PITCH=DM, ATTN_UNIT_ROWS=QB;
__device__ __forceinline__ int crow(int r,int hi){return (r&3)+8*(r>>2)+4*hi;}
#define SBAR() __builtin_amdgcn_sched_barrier(0)
__device__ __forceinline__ void cmask(f32x16&p0,f32x16&p1,int jb,int qrel,int hi){
  const float NEG=-INFINITY; int kb=64*jb+4*hi;
  #pragma unroll
  for(int r=0;r<16;++r){int kv=kb+(r&3)+8*(r>>2); if(kv>qrel)p0[r]=NEG; if(kv+32>qrel)p1[r]=NEG;}
}

constexpr int NSLOT=3, SLOTB=8192;
constexpr int LDS_K=0, LDS_V=NSLOT*SLOTB, LDS_WS=2*NSLOT*SLOTB, LDS_OST=LDS_WS+NW*64*4, LDS_BYTES=LDS_OST+NW*4096;
constexpr float C2=0.125f*1.4426950408889634f;
__device__ __forceinline__ void glds16(const void*sbase,unsigned voff,unsigned lds_dst){unsigned keep;
  asm volatile("s_mov_b32 %0, m0\n\ts_mov_b32 m0, %3\n\ts_nop 0\n\tglobal_load_lds_dwordx4 %1, %2\n\ts_mov_b32 m0, %0":"=&s"(keep):"v"(voff),"s"(sbase),"s"(lds_dst):"memory");}
__device__ __forceinline__ float max3f(float a,float b,float c){float r;asm("v_max3_f32 %0, %1, %2, %3":"=v"(r):"v"(a),"v"(b),"v"(c));return r;}
__device__ __forceinline__ float max2f(float a,float b){float r;asm("v_max_f32_e32 %0, %1, %2":"=v"(r):"v"(a),"v"(b));return r;}
__device__ __forceinline__ float fadd_s(float a,float b){float r;asm("v_add_f32_e32 %0, %1, %2":"=v"(r):"v"(a),"v"(b));return r;}
__device__ __forceinline__ float fsub_s(float a,float b){float r;asm("v_sub_f32_e32 %0, %1, %2":"=v"(r):"v"(a),"v"(b));return r;}
typedef float f32x2_t __attribute__((ext_vector_type(2))); typedef __bf16 bf16x2_t __attribute__((ext_vector_type(2)));
__device__ __forceinline__ unsigned cvtpk_s(float lo,float hi){f32x2_t v={lo,hi};bf16x2_t b=__builtin_convertvector(v,bf16x2_t);return __builtin_bit_cast(unsigned,b);}
#define WAIT_BAR(N) asm volatile("s_waitcnt vmcnt(" #N ") lgkmcnt(0)\n\ts_barrier":::"memory")

__device__ __forceinline__ void qkt(f32x16&p0,f32x16&p1,const char*Kslot,const bf16x8*qr,int r32,int hi){
  const char*kb=Kslot+hi*1024+r32*16;
  #pragma unroll
  for(int d0=0;d0<4;++d0){
    const bf16x8 b0=*reinterpret_cast<const bf16x8*>(kb+d0*2048);
    const bf16x8 b1=*reinterpret_cast<const bf16x8*>(kb+d0*2048+512);
    {p0=__builtin_amdgcn_mfma_f32_32x32x16_bf16(b0,qr[d0],p0,0,0,0);p1=__builtin_amdgcn_mfma_f32_32x32x16_bf16(b1,qr[d0],p1,0,0,0);}}
}
typedef __attribute__((address_space(3))) const char* lds_cptr;
typedef short v4i16_t __attribute__((ext_vector_type(4)));
__device__ __forceinline__ void kload8(bf16x8*kf,lds_cptr kp){
  kf[0]=*(const __attribute__((address_space(3))) bf16x8*)(kp);      kf[1]=*(const __attribute__((address_space(3))) bf16x8*)(kp+512);
  kf[2]=*(const __attribute__((address_space(3))) bf16x8*)(kp+2048); kf[3]=*(const __attribute__((address_space(3))) bf16x8*)(kp+2560);
  kf[4]=*(const __attribute__((address_space(3))) bf16x8*)(kp+4096); kf[5]=*(const __attribute__((address_space(3))) bf16x8*)(kp+4608);
  kf[6]=*(const __attribute__((address_space(3))) bf16x8*)(kp+6144); kf[7]=*(const __attribute__((address_space(3))) bf16x8*)(kp+6656);
}
__device__ __forceinline__ void kload2(bf16x8*kf,lds_cptr kp,int j){ kf[2*j]=*(const __attribute__((address_space(3))) bf16x8*)(kp+j*2048); kf[2*j+1]=*(const __attribute__((address_space(3))) bf16x8*)(kp+j*2048+512); }
__device__ __forceinline__ s16x4 vtr(lds_cptr p){ return __builtin_bit_cast(s16x4,__builtin_amdgcn_ds_read_tr16_b64_v4i16((__attribute__((address_space(3))) v4i16_t*)p)); }
__device__ __forceinline__ float rowmax(const f32x16&p0,const f32x16&p1){
  float a=max3f(p0[0],p0[1],p1[0]),b=max3f(p0[2],p0[3],p1[1]);a=max3f(a,p1[2],p1[3]);
  #pragma unroll
  for(int r=4;r<16;r+=4){a=max3f(a,p0[r],p0[r+1]);b=max3f(b,p0[r+2],p0[r+3]);a=max3f(a,p1[r],p1[r+1]);b=max3f(b,p1[r+2],p1[r+3]);}
  const float m=max2f(a,b);
  auto rr=__builtin_amdgcn_permlane32_swap(__float_as_uint(m),__float_as_uint(m),false,false);
  return max2f(__uint_as_float(rr[0]),__uint_as_float(rr[1]));
}
__device__ __forceinline__ void pv(f32x16*o,int vb,bf16x8 pa0,bf16x8 pa1,bf16x8 pa2,bf16x8 pa3){
  #pragma unroll
  for(int d0=0;d0<2;++d0){s16x4 lo[4],hi[4];
    #pragma unroll
    for(int ks=0;ks<4;++ks){
      asm volatile("ds_read_b64_tr_b16 %0,%1 offset:%c2":"=&v"(lo[ks]):"v"(vb),"i"(d0*4096+ks*1024):"memory");
      asm volatile("ds_read_b64_tr_b16 %0,%1 offset:%c2":"=&v"(hi[ks]):"v"(vb),"i"(d0*4096+ks*1024+512):"memory");}
    asm volatile("s_waitcnt lgkmcnt(0)":::"memory");SBAR();
    #define PK(k) (bf16x8){lo[k][0],lo[k][1],lo[k][2],lo[k][3],hi[k][0],hi[k][1],hi[k][2],hi[k][3]}
    o[d0]=__builtin_amdgcn_mfma_f32_32x32x16_bf16(pa0,PK(0),o[d0],0,0,0);
    o[d0]=__builtin_amdgcn_mfma_f32_32x32x16_bf16(pa1,PK(1),o[d0],0,0,0);
    o[d0]=__builtin_amdgcn_mfma_f32_32x32x16_bf16(pa2,PK(2),o[d0],0,0,0);
    o[d0]=__builtin_amdgcn_mfma_f32_32x32x16_bf16(pa3,PK(3),o[d0],0,0,0);
    #undef PK
  }
}

#ifndef ATTN_STORE16
#define ATTN_STORE16(p,v) (*(u32x4*)(p)=(v))
#endif
typedef __attribute__((address_space(3))) const float* lds_fptr; typedef float f32x4a __attribute__((ext_vector_type(4)));
__device__ __forceinline__ void gload(f32x16&c0,f32x16&c1,lds_fptr g){
  #pragma unroll
  for(int q=0;q<4;++q){const f32x4a a=*(const __attribute__((address_space(3))) f32x4a*)(g+8*q),b=*(const __attribute__((address_space(3))) f32x4a*)(g+32+8*q);
    c0[4*q]=a[0];c0[4*q+1]=a[1];c0[4*q+2]=a[2];c0[4*q+3]=a[3];c1[4*q]=b[0];c1[4*q+1]=b[1];c1[4*q+2]=b[2];c1[4*q+3]=b[3];}
}
template<int THRL> __device__ __forceinline__ void attn_unit(int b,int h,int qb,const bf16*Q,const bf16*__restrict__ K,const bf16*__restrict__ V,bf16*O,char*shm,lds_fptr fk,int ts){
  const int tid=threadIdx.x,lane=tid&63,r32=lane&31,hi=lane>>5; const int wid=__builtin_amdgcn_readfirstlane(tid>>6);
  const long rowbase=(long)b*SEQ; const int q0=qb*QB;
  const bf16*Qw=Q+(rowbase+q0+wid*QBLK)*DM+h*D;
  const bf16*Kh=K+(rowbase+(long)ts*KVBLK)*DM+h*D,*Vh=V+(rowbase+(long)ts*KVBLK)*DM+h*D;
  const unsigned lds0=(unsigned)(uintptr_t)shm;
  float*wsf=(float*)(shm+LDS_WS)+wid*64;
  const bf16*ksrc=Kh+wid*8; const unsigned koff=(unsigned)lane*DM*2u;
  const bf16*vsrc=Vh+(long)(16*(wid&3))*DM+(wid>>2)*32; const unsigned voff=((unsigned)(lane>>2)*DM+(unsigned)(lane&3)*8u)*2u;
  const unsigned kdst=lds0+LDS_K+wid*1024, vdst=lds0+LDS_V+wid*1024;
  #define DMA_K(t,slot) glds16(ksrc+(long)(t)*KVBLK*DM,koff,(unsigned)__builtin_amdgcn_readfirstlane(kdst+(slot)))
  #define DMA_V(t,slot) glds16(vsrc+(long)(t)*KVBLK*DM,voff,(unsigned)__builtin_amdgcn_readfirstlane(vdst+(slot)))
  const char*Kbase=shm+LDS_K; bf16x8 kf[8];
  const lds_cptr shm3=(lds_cptr)shm; const lds_cptr kp0=shm3+LDS_K+hi*1024+r32*16; const lds_cptr vp0=shm3+LDS_V+((lane>>4)&1)*32+(lane&3)*8+(4*hi+((lane&15)>>2))*64;
  const int NT=(q0+QB)/KVBLK-ts;
  DMA_K(0,0);DMA_V(0,0);DMA_K(1,SLOTB);
  bf16x8 qr[4];
  #pragma unroll
  for(int d0=0;d0<4;++d0)qr[d0]=*reinterpret_cast<const bf16x8*>(&Qw[(long)r32*DM+d0*16+hi*8]);
  float mhat=0.f,l_reg=0.f;f32x16 o[2];o[0]=f32x16{};o[1]=f32x16{};
  #define GP0() ({ int hh_=hi; asm volatile("":"+v"(hh_)); fk+4*hh_; })
  const int qrel=wid*QBLK+r32;
  #define CMASK(P0,P1,t) do{int jb_=(t)-(NT-4); if(jb_>=0)cmask(P0,P1,jb_,qrel,hi);}while(0)
  bool resc=false;
  #define START(P0,P1) do{ const float rm=rowmax(P0,P1); resc=false; \
    { const float dl=rm; mhat=fadd_s(mhat,dl); \
      _Pragma("unroll") for(int r=0;r<16;++r){P0[r]=fsub_s(P0[r],dl);P1[r]=fsub_s(P1[r],dl);} } \
    _Pragma("unroll") for(int r=0;r<16;++r)P0[r]=__builtin_amdgcn_exp2f(P0[r]); }while(0)
  #define RESC() do{ if(resc){ asm volatile("s_waitcnt lgkmcnt(0)":::"memory"); \
      _Pragma("unroll") for(int d_=0;d_<2;++d_) _Pragma("unroll") for(int r=0;r<16;++r)o[d_][r]*=wsf[crow(r,hi)]; } }while(0)
  f32x16 pA0,pA1,pB0,pB1;
  int sl_prev=0,sl_cur=0,sl_next=SLOTB;
  #define ROT() do{sl_prev=sl_cur;sl_cur=sl_next;sl_next=(sl_next==(NSLOT-1)*SLOTB)?0:sl_next+SLOTB;}while(0)
  DMA_K(2,2*SLOTB);
  WAIT_BAR(3);
  gload(pA0,pA1,GP0()); qkt(pA0,pA1,Kbase,qr,r32,hi);asm volatile("s_nop 15\n\ts_nop 7":"+v"(pA0),"+v"(pA1));CMASK(pA0,pA1,0);
  START(pA0,pA1);
  _Pragma("unroll") for(int r=0;r<16;++r)pA1[r]=__builtin_amdgcn_exp2f(pA1[r]);
  WAIT_BAR(0);
  DMA_K(3,0);DMA_V(1,SLOTB);
  ROT();
  kload8(kf,kp0+sl_cur);
  gload(pB0,pB1,GP0()+64);
  WAIT_BAR(2);
  s16x4 vlo[8],vhi[8]; u32x4 pw0,pw1,pw2,pw3;
  #define PKW(P,B) cvtpk_s(P[B],P[B+1])
  #define PAF(k) __builtin_bit_cast(bf16x8,pw##k)
  #define VFR(i) (bf16x8){vlo[i][0],vlo[i][1],vlo[i][2],vlo[i][3],vhi[i][0],vhi[i][1],vhi[i][2],vhi[i][3]}
  #define PIN(x) asm volatile("":"+v"(x))
  #define MX3(a,b,c) __builtin_fmaxf(__builtin_fmaxf((a),(b)),(c))
  #define GAPA(MF,A0,A1,A2,A3,W0,W1,PW) do{ MF; sacc+=A0; sacc+=A1; sacc+=A2; sacc+=A3; PIN(sacc); W0; W1; PIN(PW); SBAR(); }while(0)
  #define EX(v) __builtin_amdgcn_exp2f(v)
  #define GAPB(MF,X,B) do{ MF; X[B]=EX(X[B]); X[B+1]=EX(X[B+1]); X[B+2]=EX(X[B+2]); X[B+3]=EX(X[B+3]); PIN(X); SBAR(); }while(0)
  #define VRD(i) do{ vlo[i]=vtr(vp_+(((i)>>2)*4096+((i)&3)*1024)); vhi[i]=vtr(vp_+(((i)>>2)*4096+((i)&3)*1024+512)); }while(0)
  #define KRD(G,j) do{ if(G){ kload2(kf,kp0+sl_next,j); SBAR(); } }while(0)
  #define STEP(C0,C1,P0,P1,t,GK,GV,GL) do{ SBAR(); \
    const lds_cptr vp_=vp0+sl_prev; \
    VRD(0); SBAR(); float sacc=(P0[0]+P0[1]); \
    GAPA(C0=__builtin_amdgcn_mfma_f32_32x32x16_bf16(kf[0],qr[0],C0,0,0,0), P0[2],P0[3],P0[4],P0[5],     pw0[0]=PKW(P0,0), pw0[1]=PKW(P0,2), pw0); \
    VRD(4); SBAR(); GAPA(C1=__builtin_amdgcn_mfma_f32_32x32x16_bf16(kf[1],qr[0],C1,0,0,0), P0[6],P0[7],P0[8],P0[9],     pw0[2]=PKW(P0,4), pw0[3]=PKW(P0,6), pw0); \
    VRD(1); SBAR(); GAPA(C0=__builtin_amdgcn_mfma_f32_32x32x16_bf16(kf[2],qr[1],C0,0,0,0),   P0[10],P0[11],P0[12],P0[13], pw1[0]=PKW(P0,8), pw1[1]=PKW(P0,10), pw1); \
    VRD(5); SBAR(); GAPA(C1=__builtin_amdgcn_mfma_f32_32x32x16_bf16(kf[3],qr[1],C1,0,0,0),   P0[14],P0[15],P1[0],P1[1],   pw1[2]=PKW(P0,12),pw1[3]=PKW(P0,14), pw1); \
    VRD(2); SBAR(); GAPA(C0=__builtin_amdgcn_mfma_f32_32x32x16_bf16(kf[4],qr[2],C0,0,0,0),   P1[2],P1[3],P1[4],P1[5],     pw2[0]=PKW(P1,0), pw2[1]=PKW(P1,2), pw2); \
    VRD(6); SBAR(); GAPA(C1=__builtin_amdgcn_mfma_f32_32x32x16_bf16(kf[5],qr[2],C1,0,0,0),   P1[6],P1[7],P1[8],P1[9],     pw2[2]=PKW(P1,4), pw2[3]=PKW(P1,6), pw2); \
    VRD(3); SBAR(); GAPA(C0=__builtin_amdgcn_mfma_f32_32x32x16_bf16(kf[6],qr[3],C0,0,0,0),   P1[10],P1[11],P1[12],P1[13], pw3[0]=PKW(P1,8), pw3[1]=PKW(P1,10), pw3); \
    VRD(7); SBAR(); GAPA(C1=__builtin_amdgcn_mfma_f32_32x32x16_bf16(kf[7],qr[3],C1,0,0,0),   P1[14],P1[15],0.f,0.f,       pw3[2]=PKW(P1,12),pw3[3]=PKW(P1,14), pw3); \
    l_reg+=sacc; \
    if(GK){DMA_K((t)+3,sl_cur);} if(GV){DMA_V((t)+1,sl_next);} \
    CMASK(C0,C1,t); \
    { float a=MX3(C0[0],C0[1],C1[0]),b=MX3(C0[2],C0[3],C1[1]); a=MX3(a,C1[2],C1[3]); \
      _Pragma("unroll") for(int r=4;r<16;r+=4){a=MX3(a,C0[r],C0[r+1]);b=MX3(b,C0[r+2],C0[r+3]);a=MX3(a,C1[r],C1[r+1]);b=MX3(b,C1[r+2],C1[r+3]);} \
      float rm=__builtin_fmaxf(a,b); { auto rr=__builtin_amdgcn_permlane32_swap(__float_as_uint(rm),__float_as_uint(rm),false,false); rm=__builtin_fmaxf(__uint_as_float(rr[0]),__uint_as_float(rr[1])); } \
      resc=false; const float dlt=rm-mhat; \
      if(__any(dlt>(float)THRL)){ const float dl=__builtin_fmaxf(dlt,0.f); mhat+=dl; \
        const float f=__builtin_amdgcn_exp2f(-dl); l_reg*=f; if(hi==0)wsf[r32]=f; resc=true; } \
      _Pragma("unroll") for(int r=0;r<16;++r){C0[r]-=mhat;C1[r]-=mhat;} } \
    SBAR(); \
    GAPB(o[0]=__builtin_amdgcn_mfma_f32_32x32x16_bf16(PAF(0),VFR(0),o[0],0,0,0), C0,0); \
    GAPB(o[1]=__builtin_amdgcn_mfma_f32_32x32x16_bf16(PAF(0),VFR(4),o[1],0,0,0), C0,4); \
    KRD(GL,0); GAPB(o[0]=__builtin_amdgcn_mfma_f32_32x32x16_bf16(PAF(1),VFR(1),o[0],0,0,0), C0,8); \
    KRD(GL,1); GAPB(o[1]=__builtin_amdgcn_mfma_f32_32x32x16_bf16(PAF(1),VFR(5),o[1],0,0,0), C0,12); \
    KRD(GL,2); GAPB(o[0]=__builtin_amdgcn_mfma_f32_32x32x16_bf16(PAF(2),VFR(2),o[0],0,0,0), C1,0); \
    KRD(GL,3); GAPB(o[1]=__builtin_amdgcn_mfma_f32_32x32x16_bf16(PAF(2),VFR(6),o[1],0,0,0), C1,4); \
    GAPB(o[0]=__builtin_amdgcn_mfma_f32_32x32x16_bf16(PAF(3),VFR(3),o[0],0,0,0), C1,8); \
    GAPB(o[1]=__builtin_amdgcn_mfma_f32_32x32x16_bf16(PAF(3),VFR(7),o[1],0,0,0), C1,12); \
    if(GL){ gload(P0,P1,GP0()+((t)+1)*64); } \
    }while(0)
  int t=1;
  #undef CMASK
  #define CMASK(P0,P1,t) do{}while(0)
  for(;t+5<NT;t+=2){
    STEP(pB0,pB1,pA0,pA1,t,true,true,true);     WAIT_BAR(2); RESC(); ROT();
    STEP(pA0,pA1,pB0,pB1,t+1,true,true,true);   WAIT_BAR(2); RESC(); ROT();
  }
  #undef CMASK
  #define CMASK(P0,P1,t) do{int jb_=(t)-(NT-4); if(jb_>=0)cmask(P0,P1,jb_,qrel,hi);}while(0)
  #define ENDW(tt) do{ if((tt)+3<NT){WAIT_BAR(2);} else if((tt)+2<NT){WAIT_BAR(1);} else {WAIT_BAR(0);} }while(0)
  for(;t+1<NT;t+=2){
    STEP(pB0,pB1,pA0,pA1,t,(t+3<NT),(t+1<NT),(t+1<NT));       ENDW(t);   RESC(); ROT();
    STEP(pA0,pA1,pB0,pB1,t+1,(t+4<NT),(t+2<NT),(t+2<NT));     ENDW(t+1); RESC(); ROT();
  }
  STEP(pB0,pB1,pA0,pA1,NT-1,false,false,false); RESC();
  { float sacc=pB0[0]+pB0[1]; _Pragma("unroll") for(int r=2;r<16;++r)sacc+=pB0[r]; _Pragma("unroll") for(int r=0;r<16;++r)sacc+=pB1[r]; l_reg+=sacc;
    pw0=(u32x4){PKW(pB0,0),PKW(pB0,2),PKW(pB0,4),PKW(pB0,6)};pw1=(u32x4){PKW(pB0,8),PKW(pB0,10),PKW(pB0,12),PKW(pB0,14)};pw2=(u32x4){PKW(pB1,0),PKW(pB1,2),PKW(pB1,4),PKW(pB1,6)};pw3=(u32x4){PKW(pB1,8),PKW(pB1,10),PKW(pB1,12),PKW(pB1,14)};
    SBAR(); pv(o,(int)(unsigned)(__UINTPTR_TYPE__)(vp0+sl_cur),PAF(0),PAF(1),PAF(2),PAF(3)); }
  #undef PKW
  #undef PAF
  #undef VFR
  #undef PIN
  #undef MX3
  #undef GAPA
  #undef GAPB
  #undef EX
  #undef VRD
  #undef KRD
  #undef STEP
  #undef ENDW
  {auto rr=__builtin_amdgcn_permlane32_swap(__float_as_uint(l_reg),__float_as_uint(l_reg),false,false);l_reg=__uint_as_float(rr[0])+__uint_as_float(rr[1]);}
  if(hi==0)wsf[32+r32]=l_reg;asm volatile("s_waitcnt lgkmcnt(0)":::"memory");
  float rli[16];
  #pragma unroll
  for(int r=0;r<16;++r)rli[r]=__builtin_amdgcn_rcpf(wsf[32+crow(r,hi)]);
  bf16*Ow=O+(rowbase+q0+wid*QBLK)*OPITCH+h*D;
  { bf16*stg=(bf16*)(shm+LDS_OST)+wid*2048;
    #pragma unroll
    for(int r=0;r<16;++r){const int orow=crow(r,hi);
      #pragma unroll
      for(int d0=0;d0<2;++d0)stg[orow*64+d0*32+r32]=__float2bfloat16(o[d0][r]*rli[r]);}
    asm volatile("s_waitcnt lgkmcnt(0)":::"memory");
    #pragma unroll
    for(int i=0;i<4;++i){const int row=i*8+(lane>>3),ch=lane&7; const u32x4 v=*(const u32x4*)(stg+row*64+ch*8); ATTN_STORE16(Ow+(long)row*OPITCH+ch*8,v);} }
  asm volatile("s_waitcnt lgkmcnt(0)\n\ts_barrier":::"memory");
  #undef DMA_K
  #undef DMA_V
  #undef CMASK
  #undef START
  #undef RESC
  #undef ROT
}
constexpr int ATTN_LDS_BYTES=LDS_BYTES;
struct AttnTensors { const bf16* Q; const bf16* K; const bf16* V; bf16* O; };
struct AttnUnit { int bh; int qb; };
struct StaticOrder {
  int vcu;
  __device__ __forceinline__ explicit StaticOrder(int grid,int block):vcu((block%8)*(grid/8)+block/8){}
  __device__ __forceinline__ bool next(int i,AttnUnit&u)const{ if(i>=4)return false; const int s=vcu&7; u.bh=vcu>>3; u.qb=(i==0)?s:(i==1)?15-s:(i==2)?16+s:31-s; return true; }
  __device__ __forceinline__ void a_ready(const AttnUnit&)const{}
  __device__ __forceinline__ void done(const AttnUnit&)const{}
};
#undef SBAR
#undef WAIT_BAR
}
namespace cg = cooperative_groups;
#ifndef MK_COOP
#define MK_COOP 1
#endif
constexpr int NWAVES = 8;
constexpr int BATCH = 2, T = 8192, D = 1024, M = BATCH * T, NH = 8, HD = 64, CW = 512, DFF = 2816, NUP = 2 * DFF, NIN = 5120, INW = 5128, NMOD = 6 * D;
constexpr float RMS_EPS = 1e-6f, LOG2E = 1.4426950408889634f;
constexpr int N_PHASES = 12;
constexpr size_t MiB = 1u << 20;
constexpr size_t WS_CTL = 0, CTL_ZERO_BYTES = 81920;
constexpr size_t WS_MODACC = 4096, WS_SSQ = 131072, WS_CVEC = 262144;
constexpr size_t WS_UNITCTR = 512, WS_UINFO = 524288;
constexpr size_t WS_LF = 1 * MiB, WS_G = WS_LF + 512 * 1024;
constexpr size_t WS_WIN = 2 * MiB, WS_WAB = 12 * MiB, WS_WOUT = 14 * MiB, WS_WUP = 16 * MiB, WS_WDN = 27 * MiB;
constexpr size_t WS_XN = 34 * MiB, WS_YAB = WS_XN;
constexpr size_t WS_CB = 66 * MiB, WS_CC = 82 * MiB, WS_CV = 98 * MiB, WS_Q = 114 * MiB, WS_K = 130 * MiB, WS_V = 146 * MiB, WS_GA = 162 * MiB, WS_GB = 194 * MiB;
constexpr size_t WS_MERGED = 66 * MiB;
constexpr size_t WS_UH = 66 * MiB, WS_ACT = 154 * MiB, WS_END = 242 * MiB;
static_assert(WS_WDN + (size_t)D * DFF * 2 <= WS_XN && WS_UH + (size_t)T * NUP * 2 <= WS_ACT && WS_ACT + (size_t)M * DFF * 2 <= WS_END, "ws map");

#define LAS __attribute__((address_space(3)))
typedef unsigned short bfu;
typedef unsigned v4u __attribute__((ext_vector_type(4)));
typedef float f32x4 __attribute__((ext_vector_type(4)));
#define LDS_WAIT() asm volatile("s_waitcnt lgkmcnt(0)" ::: "memory")
__device__ __forceinline__ unsigned f2bf(float f) { unsigned u = __builtin_bit_cast(unsigned, f); return (u + 0x7fffu + ((u >> 16) & 1u)) >> 16; }
__device__ __forceinline__ unsigned pk2(float lo, float hi) { unsigned r; asm("v_cvt_pk_bf16_f32 %0, %1, %2" : "=v"(r) : "v"(lo), "v"(hi)); return r; }
__device__ __forceinline__ float blo(unsigned w) { return __uint_as_float(w << 16); }
__device__ __forceinline__ float bhi(unsigned w) { return __uint_as_float(w & 0xffff0000u); }
__device__ __forceinline__ float wave_sum(float v) {
#pragma unroll
    for (int o = 1; o < 64; o <<= 1) v += __shfl_xor(v, o);
    return v;
}
__device__ __forceinline__ float siluf_(float x) { return x * __builtin_amdgcn_rcpf(1.0f + __expf(-x)); }

#define XB_TMO      128
#define XB_XCNT(j)  (256  + 64 * (j))
#define XB_XSUB(j)  (1280 + 64 * (j))
#define XB_XGEN(j)  (2304 + 64 * (j))
#define XB_TOP      3328
#define XB_TOPGEN   3392
#define XCD_BAR_WORDS 3456
#define XB_SPIN_CAP (1u << 18)

__device__ __forceinline__ unsigned xb_ld(unsigned* p)              { return __hip_atomic_load(p, __ATOMIC_RELAXED, __HIP_MEMORY_SCOPE_AGENT); }
__device__ __forceinline__ unsigned xb_add(unsigned* p, unsigned v) { return __hip_atomic_fetch_add(p, v, __ATOMIC_RELAXED, __HIP_MEMORY_SCOPE_AGENT); }
__device__ __forceinline__ unsigned xb_xcc_id() { return (unsigned)__builtin_amdgcn_s_getreg((3 << 11) | 20) & 0xFu; }
#define XB_SPIN(cond, bar) do { unsigned _sp = 0; while (cond) { __builtin_amdgcn_s_sleep(1); \
    if ((++_sp & 255u) == 0u) { if (xb_ld(&(bar)[XB_TMO])) break; if (_sp > XB_SPIN_CAP) { atomicAdd(&(bar)[XB_TMO], 1u); break; } } } } while (0)

struct XcdBarrier {
    unsigned* bar; unsigned x;
    volatile LAS unsigned* st;
};

__device__ __forceinline__ XcdBarrier xcd_barrier_post(unsigned* bar, volatile LAS unsigned* st) {
    XcdBarrier b; b.bar = bar; b.x = xb_xcc_id(); b.st = st;
    if (threadIdx.x == 0) (void)xb_add(&bar[XB_XCNT(b.x)], 1u);
    return b;
}
__device__ __forceinline__ void xcd_barrier_complete(unsigned* bar, unsigned x, unsigned& nloc, unsigned& nx) {
    const unsigned G = gridDim.x * gridDim.y * gridDim.z;
    unsigned sum, cnt, mine, sp = 0u;
    for (;;) {
        sum = 0u; cnt = 0u; mine = 0u;
#pragma unroll
        for (unsigned j = 0; j < 16; ++j) { const unsigned c = xb_ld(&bar[XB_XCNT(j)]); sum += c; cnt += (c > 0u) ? 1u : 0u; mine = (j == x) ? c : mine; }
        if (sum == G) break;
        __builtin_amdgcn_s_sleep(1);
        if ((++sp & 255u) == 0u) { if (xb_ld(&bar[XB_TMO])) break; if (sp > XB_SPIN_CAP) { atomicAdd(&bar[XB_TMO], 1u); break; } }
    }
    nloc = mine > 0u ? mine : 1u; nx = cnt > 0u ? cnt : 1u;
}

__device__ __forceinline__ void xcd_barrier(const XcdBarrier& b) {
    asm volatile("s_waitcnt vmcnt(0)" ::: "memory");
    __syncthreads();
    if (threadIdx.x == 0) {
        unsigned* bar = b.bar;
        __builtin_amdgcn_s_waitcnt(0);
        unsigned nloc = b.st[0], nx = b.st[1];
        if (nloc == 0u) { xcd_barrier_complete(bar, b.x, nloc, nx); b.st[0] = nloc; b.st[1] = nx; }
        const unsigned old = xb_add(&bar[XB_XSUB(b.x)], 1u);
        const unsigned gen = old / nloc;
        if (old + 1u == (gen + 1u) * nloc) {
            __builtin_amdgcn_fence(__ATOMIC_RELEASE, "agent");
            asm volatile("s_waitcnt vmcnt(0)" ::: "memory");
            const unsigned og = xb_add(&bar[XB_TOP], 1u);
            const unsigned tg = og / nx;
            if (og + 1u == (tg + 1u) * nx) xb_add(&bar[XB_TOPGEN], 1u);
            else XB_SPIN(xb_ld(&bar[XB_TOPGEN]) == tg, bar);
            __builtin_amdgcn_fence(__ATOMIC_ACQUIRE, "agent");
            xb_add(&bar[XB_XGEN(b.x)], 1u);
            asm volatile("s_waitcnt vmcnt(0)" ::: "memory");
        } else {
            XB_SPIN(xb_ld(&bar[XB_XGEN(b.x)]) == gen, bar);
            __builtin_amdgcn_fence(__ATOMIC_ACQUIRE, "agent");
            asm volatile("s_waitcnt vmcnt(0)" ::: "memory");
        }
    }
    __syncthreads();
}
__device__ __forceinline__ void grid_bar(unsigned* ctr, unsigned target) {
    asm volatile("s_waitcnt vmcnt(0) lgkmcnt(0)" ::: "memory");
    __syncthreads();
    if (threadIdx.x == 0) {
        __builtin_amdgcn_fence(__ATOMIC_RELEASE, "agent");
        asm volatile("s_waitcnt vmcnt(0)" ::: "memory");
        __hip_atomic_fetch_add(ctr, 1u, __ATOMIC_RELAXED, __HIP_MEMORY_SCOPE_AGENT);
        while (__hip_atomic_load(ctr, __ATOMIC_RELAXED, __HIP_MEMORY_SCOPE_AGENT) < target) __builtin_amdgcn_s_sleep(2);
        __builtin_amdgcn_fence(__ATOMIC_ACQUIRE, "agent");
        asm volatile("s_waitcnt vmcnt(0)" ::: "memory");
    }
    __syncthreads();
}
struct Args { const float* in[17]; float* out; unsigned char* ws; int ph_lo, ph_hi; };
enum { I_X = 0, I_C, I_WADA, I_BADA, I_N1G, I_WIN, I_BF, I_CONVA, I_QG, I_KG, I_WBA, I_WBB, I_WOUT, I_N2G, I_WUP, I_CONVF, I_WDN };

__device__ __forceinline__ void transpose_item(const float* W, int ldw, int k0, int c0, bfu* WT, int K, int dk0, int drow0, LAS float* scr, int lane) {
    { const int kr = lane >> 3, nc = (lane & 7) * 4; f32x4 v[8];
#pragma unroll
      for (int i = 0; i < 8; ++i) v[i] = __builtin_nontemporal_load((const f32x4*)(W + (size_t)(k0 + 8 * i + kr) * ldw + c0 + nc));
#pragma unroll
      for (int i = 0; i < 8; ++i) { LAS float* d = scr + (8 * i + kr) * 33 + nc; d[0] = v[i].x; d[1] = v[i].y; d[2] = v[i].z; d[3] = v[i].w; } }
    LDS_WAIT(); asm volatile("" ::: "memory");
    const int c = lane & 7;
#pragma unroll
    for (int j = 0; j < 4; ++j) { const int n = (lane >> 3) + 8 * j; const LAS float* s = scr + (8 * c) * 33 + n;
        v4u o; o.x = pk2(s[0 * 33], s[1 * 33]); o.y = pk2(s[2 * 33], s[3 * 33]); o.z = pk2(s[4 * 33], s[5 * 33]); o.w = pk2(s[6 * 33], s[7 * 33]);
        *(v4u*)(WT + (size_t)(drow0 + n) * K + dk0 + 8 * c) = o; }
    LDS_WAIT(); asm volatile("" ::: "memory");
}

template <int NK = 64> __device__ __forceinline__ void gemv2_item(const float* W, int ldw, int n0, int k0, float c0, float c1, float* out0, float* out1, int lane) {
    f32x4 s0 = {0.f, 0.f, 0.f, 0.f}, s1 = {0.f, 0.f, 0.f, 0.f};
    const float* wp = W + (size_t)k0 * ldw + n0 + 4 * lane;
#pragma unroll 16
    for (int kk = 0; kk < NK; ++kk) { const f32x4 w = __builtin_nontemporal_load((const f32x4*)(wp + (size_t)kk * ldw)); s0 += w * __shfl(c0, kk); s1 += w * __shfl(c1, kk); }
    float* o0 = out0 + n0 + 4 * lane; float* o1 = out1 + n0 + 4 * lane;
    atomicAdd(o0, s0.x); atomicAdd(o0 + 1, s0.y); atomicAdd(o0 + 2, s0.z); atomicAdd(o0 + 3, s0.w);
    atomicAdd(o1, s1.x); atomicAdd(o1 + 1, s1.y); atomicAdd(o1 + 2, s1.z); atomicAdd(o1 + 3, s1.w);
}
template <bool FLOG>
__device__ __forceinline__ void norm_rows(const float* X, const float* gain, const float* modacc, const float* bada, int sh_slot, int sc_slot, bfu* XN, const LAS float* wf, const float* bf_, float* LF, int gw, int NGW, int lane) {
    for (int m0 = gw * 8; m0 < M; m0 += NGW * 8) {
        const int b = m0 / T;
        f32x4 A[4], Bv[4];
#pragma unroll
        for (int j = 0; j < 4; ++j) { const int col = 256 * j + 4 * lane;
            const f32x4 g = *(const f32x4*)(gain + col);
            const f32x4 sc = *(const f32x4*)(modacc + b * NMOD + sc_slot * D + col) + *(const f32x4*)(bada + sc_slot * D + col);
            const f32x4 sh = *(const f32x4*)(modacc + b * NMOD + sh_slot * D + col) + *(const f32x4*)(bada + sh_slot * D + col);
            A[j] = g * (sc + 1.0f); Bv[j] = sh; }
        f32x4 vv[2][4][4];
#pragma unroll
        for (int g = 0; g < 2; ++g)
#pragma unroll
            for (int q = 0; q < 4; ++q) { const f32x4* xr = (const f32x4*)(X + (size_t)(m0 + 4 * g + q) * D) + lane;
#pragma unroll
                for (int j = 0; j < 4; ++j) vv[g][q][j] = __builtin_nontemporal_load(xr + 64 * j); }
#pragma unroll
        for (int g = 0; g < 2; ++g) { const int r0 = 4 * g;
            f32x4 (&v)[4][4] = vv[g]; float s2[4];
#pragma unroll
            for (int q = 0; q < 4; ++q) { s2[q] = 0.f;
#pragma unroll
                for (int j = 0; j < 4; ++j) s2[q] += (v[q][j].x * v[q][j].x + v[q][j].y * v[q][j].y) + (v[q][j].z * v[q][j].z + v[q][j].w * v[q][j].w); }
#pragma unroll
            for (int o = 1; o < 64; o <<= 1) {
#pragma unroll
                for (int q = 0; q < 4; ++q) s2[q] += __shfl_xor(s2[q], o); }
#pragma unroll
            for (int q = 0; q < 4; ++q) { const int m = m0 + r0 + q;
                const float inv = __builtin_amdgcn_rsqf(s2[q] * (1.0f / D) + RMS_EPS);
                unsigned long long* o8 = (unsigned long long*)(XN + (size_t)m * D) + lane;
#pragma unroll
                for (int j = 0; j < 4; ++j) { v[q][j] = v[q][j] * inv * A[j] + Bv[j];
                    o8[64 * j] = (unsigned long long)pk2(v[q][j].x, v[q][j].y) | ((unsigned long long)pk2(v[q][j].z, v[q][j].w) << 32); }
                if (FLOG) {
                    asm volatile("" ::: "memory");
                    float p[8];
#pragma unroll
                    for (int h = 0; h < 8; ++h) { p[h] = 0.f;
#pragma unroll
                        for (int j = 0; j < 4; ++j) { const f32x4 w = *(const LAS f32x4*)(wf + h * D + 256 * j + 4 * lane); p[h] += (v[q][j].x * w.x + v[q][j].y * w.y) + (v[q][j].z * w.z + v[q][j].w * w.w); } }
#pragma unroll
                    for (int h = 0; h < 4; ++h) { const float send = (lane & 1) ? p[h] : p[h + 4], keep = (lane & 1) ? p[h + 4] : p[h]; p[h] = keep + __shfl_xor(send, 1); }
#pragma unroll
                    for (int h = 0; h < 2; ++h) { const float send = (lane & 2) ? p[h] : p[h + 2], keep = (lane & 2) ? p[h + 2] : p[h]; p[h] = keep + __shfl_xor(send, 2); }
                    { const float send = (lane & 4) ? p[0] : p[1], keep = (lane & 4) ? p[1] : p[0]; p[0] = keep + __shfl_xor(send, 4); }
                    p[0] += __shfl_xor(p[0], 8); p[0] += __shfl_xor(p[0], 16); p[0] += __shfl_xor(p[0], 32);
                    if (lane < 8) { const int h = ((lane & 1) << 2) | (lane & 2) | ((lane & 4) >> 2); const float z = p[0] + bf_[h]; LF[(size_t)((m / T) * 8 + h) * T + (m % T)] = fminf(z, 0.f) - log1pf(__expf(-fabsf(z))); }
                }
            }
        }
    }
}

__global__ void __launch_bounds__(NWAVES * 64, 2) fwd_kernel(Args args) {
    extern __shared__ __attribute__((aligned(16))) unsigned char lds[];
    LAS unsigned char* ldsp = (LAS unsigned char*)lds;
    const int wave = __builtin_amdgcn_readfirstlane((int)threadIdx.x >> 6);
    const int G = gridDim.x; const int bx = blockIdx.x; const int vcu = (G % 8 == 0) ? (bx % 8) * (G / 8) + bx / 8 : bx;
    const int gw = vcu * NWAVES + wave, NGW = G * NWAVES;
#define PH_IDS int tid = threadIdx.x; asm volatile("" : "+v"(tid)); const int lane = tid & 63; (void)lane
    unsigned char* ws = args.ws;
    float* modacc = (float*)(ws + WS_MODACC);
    float* ssq = (float*)(ws + WS_SSQ); float* cvec = (float*)(ws + WS_CVEC);
    float* LF = (float*)(ws + WS_LF); float* GF = (float*)(ws + WS_G);
    bfu *Win_t = (bfu*)(ws + WS_WIN), *Wab_t = (bfu*)(ws + WS_WAB), *Wout_t = (bfu*)(ws + WS_WOUT), *Wup_t = (bfu*)(ws + WS_WUP), *Wdn_t = (bfu*)(ws + WS_WDN);
    bfu *XN = (bfu*)(ws + WS_XN), *YAB = (bfu*)(ws + WS_YAB), *CB = (bfu*)(ws + WS_CB), *CC = (bfu*)(ws + WS_CC), *CV = (bfu*)(ws + WS_CV);
    bfu *QB = (bfu*)(ws + WS_Q), *KB = (bfu*)(ws + WS_K), *VB = (bfu*)(ws + WS_V), *GA = (bfu*)(ws + WS_GA), *GB = (bfu*)(ws + WS_GB);
    bfu* X1B = (bfu*)(ws + 100 * MiB);
    bfu *MERGED = (bfu*)(ws + WS_MERGED), *UH = (bfu*)(ws + WS_UH), *ACT = (bfu*)(ws + WS_ACT);
    const float* x = args.in[I_X]; float* out = args.out; const float* bada = args.in[I_BADA];
    const int lo = args.ph_lo, hi = args.ph_hi;
#ifndef PHMASK
#define PHMASK 0xfff
#endif
#define IN(k) (((PHMASK >> (k)) & 1) && lo <= (k) && (k) < hi)
    { volatile LAS unsigned* misc = (volatile LAS unsigned*)(ldsp + 146432); if (threadIdx.x < 2) misc[threadIdx.x] = 0u; __syncthreads(); }
    if (args.ph_lo < 0) cg::this_grid().sync();
    const XcdBarrier xbar = xcd_barrier_post((unsigned*)(ws + WS_CTL + 65536), (volatile LAS unsigned*)(ldsp + 146432));
    unsigned* barctr = (unsigned*)(ws + WS_CTL + 256);
#define SEAM(k) do { if (IN(k) && (IN((k) + 1) || ((k) == 5 && IN(7)) || ((k) == 7 && IN(11)))) { xcd_barrier(xbar); } } while (0)

    if (IN(0)) {
        PH_IDS;
        for (int i = (vcu * NWAVES * 64) + tid; i < M; i += G * NWAVES * 64) ssq[i] = 0.f;
        { LAS float* red = (LAS float*)ldsp;
          for (int it = vcu; it < 24 * 8; it += G) {
            const int nb = it % 24, kc = it / 24, k0 = kc * 128 + wave * 16; const float* c = args.in[I_C];
            const float c0 = siluf_(c[k0 + (lane & 15)]), c1 = siluf_(c[D + k0 + (lane & 15)]);
            f32x4 s0 = {0.f, 0.f, 0.f, 0.f}, s1 = {0.f, 0.f, 0.f, 0.f};
            const float* wp = args.in[I_WADA] + (size_t)k0 * NMOD + nb * 256 + 4 * lane;
#pragma unroll
            for (int kk = 0; kk < 16; ++kk) { const f32x4 w = __builtin_nontemporal_load((const f32x4*)(wp + (size_t)kk * NMOD)); s0 += w * __shfl(c0, kk); s1 += w * __shfl(c1, kk); }
            *(LAS f32x4*)(red + (wave * 2 + 0) * 256 + 4 * lane) = s0; *(LAS f32x4*)(red + (wave * 2 + 1) * 256 + 4 * lane) = s1;
            __syncthreads();
            { const int bsel = tid >> 8, col = tid & 255; float a = 0.f;
#pragma unroll
              for (int w = 0; w < 8; ++w) a += red[(w * 2 + bsel) * 256 + col];
              atomicAdd(modacc + bsel * NMOD + nb * 256 + col, a); }
            __syncthreads();
          } }
    }
    SEAM(0);
    if (IN(1)) {
        PH_IDS;
        LAS float* wf = (LAS float*)ldsp;
        for (int k = tid; k < D; k += NWAVES * 64) { const float* src = args.in[I_WIN] + (size_t)k * INW + 3072; const f32x4 a = *(const f32x4*)src, b = *(const f32x4*)(src + 4);
            wf[0 * D + k] = a.x; wf[1 * D + k] = a.y; wf[2 * D + k] = a.z; wf[3 * D + k] = a.w; wf[4 * D + k] = b.x; wf[5 * D + k] = b.y; wf[6 * D + k] = b.z; wf[7 * D + k] = b.w; }
        __syncthreads();
        norm_rows<true>(x, args.in[I_N1G], modacc, bada, 0, 1, XN, wf, args.in[I_BF], LF, gw, NGW, lane);
        {
            LAS float* scr = (LAS float*)(ldsp + 32768 + wave * 8448);
            constexpr int I_IN = 16 * 160, I_AB = 16 * 32, I_OUT = 16 * 32, I_UP = 16 * 176, I_DN = 44 * 32;
            constexpr int NITEMS = I_IN + I_AB + I_OUT + I_UP + I_DN;
            for (int it = gw; it < NITEMS; it += NGW) {
                int r = it;
                if (r < I_IN) { const int kb = r / 160, db = r % 160, d0 = 32 * db, pn = d0 >> 8, s = d0 & 255;
                    int srcs = s; if (pn >= 6 && pn < 10) { const int bj = s >> 7, wc = (s >> 5) & 3; srcs = 64 * wc + 32 * bj; }
                    int col = 256 * pn + srcs; if (col >= 3072) col += 8;
                    transpose_item(args.in[I_WIN], INW, 64 * kb, col, Win_t, D, 64 * kb, d0, scr, lane); continue; }
                r -= I_IN;
                if (r < I_AB) { const int kb = r / 32, nb = r % 32;
                    transpose_item(kb < 8 ? args.in[I_WBA] : args.in[I_WBB], D, 64 * (kb & 7), 32 * nb, Wab_t, D, 64 * kb, 32 * nb, scr, lane); continue; }
                r -= I_AB;
                if (r < I_OUT) { const int kb = r / 32, nb = r % 32; transpose_item(args.in[I_WOUT], D, 64 * kb, 32 * nb, Wout_t, D, 64 * kb, 32 * nb, scr, lane); continue; }
                r -= I_OUT;
                if (r < I_UP) { const int kb = r / 176, nb = r % 176, d0 = 32 * nb; const int col = ((d0 & 255) >> 7) * DFF + 128 * (d0 >> 8) + (d0 & 127);
                    transpose_item(args.in[I_WUP], NUP, 64 * kb, col, Wup_t, D, 64 * kb, d0, scr, lane); continue; }
                r -= I_UP;
                { const int kb = r / 32, nb = r % 32; transpose_item(args.in[I_WDN], D, 64 * kb, 32 * nb, Wdn_t, DFF, 64 * kb, 32 * nb, scr, lane); }
            }
        }
        __syncthreads();
    }
    SEAM(1);
    if (IN(2)) {
        PH_IDS;
        if (bx < 16) {
            LAS float* tot = (LAS float*)(ldsp + 140 * 1024);
            const int t0 = wave * 1024 + lane * 16;
            float v[16];
            { const f32x4* lf4 = (const f32x4*)(LF + (size_t)bx * T + t0);
#pragma unroll
              for (int j = 0; j < 4; ++j) { const f32x4 q = lf4[j]; v[4 * j] = q.x; v[4 * j + 1] = q.y; v[4 * j + 2] = q.z; v[4 * j + 3] = q.w; } }
#pragma unroll
            for (int j = 1; j < 16; ++j) v[j] += v[j - 1];
            float incl = v[15];
#pragma unroll
            for (int o = 1; o < 64; o <<= 1) { const float y = __shfl_up(incl, o); if (lane >= o) incl += y; }
            const float excl = incl - v[15];
            if (lane == 63) tot[wave] = incl;
            __syncthreads();
            float off = 0.f;
            for (int w = 0; w < wave; ++w) off += tot[w];
#pragma unroll
            for (int j = 0; j < 16; ++j) GF[(size_t)bx * T + t0 + j] = -(off + excl + v[j]) * LOG2E;
            LAS float* Gl = (LAS float*)ldsp;
#pragma unroll
            for (int j = 0; j < 16; ++j) Gl[t0 + j] = -(off + excl + v[j]) * LOG2E;
            float cthr;
            { const float gq = fabsf(args.in[I_QG][lane]), gk = fabsf(args.in[I_KG][lane]); float mq = gq, mk = gk;
#pragma unroll
              for (int o = 1; o < 64; o <<= 1) { mq = fmaxf(mq, __shfl_xor(mq, o)); mk = fmaxf(mk, __shfl_xor(mk, o)); }
              cthr = 2.0f * (8.0f * mq * mk * 1.02f * LOG2E) + 32.0f; }
            __syncthreads();
            if (tid < 32) { const int qb = tid, NT = 4 * (qb + 1); const float gq0 = Gl[256 * qb]; int lo_ = 0, hi_ = NT / 2 - 2;
                while (lo_ < hi_) { const int mid = (lo_ + hi_ + 1) >> 1; if (gq0 - Gl[128 * mid - 1] > cthr) lo_ = mid; else hi_ = mid - 1; }
                ((int*)(ws + WS_UINFO))[bx * 32 + qb] = 2 * lo_; }
            __syncthreads();
        }
        pg8::Gemm g{XN, Win_t, M, NIN, D}; pg8::StaticOrder S; S.init(M, NIN, G, bx);
        pg8::EpiIn E{CB, (size_t)(16 * MiB / 2), (size_t)((WS_GA - WS_CB) / 2), (size_t)(32 * MiB / 2), args.in[I_QG], (long)(args.in[I_KG] - args.in[I_QG]), 0.125f * LOG2E, RMS_EPS};
        pg8::gemm_phase<pg8::EpiIn, pg8::StaticOrder, true, true>(ldsp, g, S, E);
    }
    SEAM(2);
    if (IN(3)) {
        PH_IDS;
        LAS float* fk = (LAS float*)(ldsp + 86016);
        LAS int* ucost = (LAS int*)(ldsp + 122880); LAS int* uord = ucost + 512; LAS int* slot = uord + 512;
        { const int u = tid; ucost[u] = 4 * ((u & 31) + 1) - ((const int*)(ws + WS_UINFO))[u]; }
        __syncthreads();
        { const int my = ucost[tid]; int rank = 0;
          for (int j = 0; j < 512; ++j) { const int c = ucost[j]; rank += (c > my || (c == my && j < tid)) ? 1 : 0; }
          uord[rank] = tid; }
        __syncthreads();
        for (;;) {
            if (threadIdx.x == 0) slot[0] = (int)__hip_atomic_fetch_add((unsigned*)(ws + WS_UNITCTR), 1u, __ATOMIC_RELAXED, __HIP_MEMORY_SCOPE_AGENT);
            __syncthreads();
            const int p = __builtin_amdgcn_readfirstlane(slot[0]);
            __syncthreads();
            if (p >= 512) break;
            const int u = __builtin_amdgcn_readfirstlane(uord[p]), bh = u >> 5, qb = u & 31, ts = __builtin_amdgcn_readfirstlane(4 * (qb + 1) - ucost[u]);
            const f32x4* gsrc = (const f32x4*)(GF + (size_t)bh * T);
            int t2 = threadIdx.x; asm volatile("" : "+v"(t2));
            for (int i = t2 + 16 * ts; i < (qb + 1) * 64; i += NWAVES * 64) ((LAS f32x4*)fk)[i] = gsrc[i];
            __syncthreads();
            attn_body::attn_unit<20>(bh >> 3, bh & 7, qb, (const attn_body::bf16*)QB, (const attn_body::bf16*)KB, (const attn_body::bf16*)VB, (attn_body::bf16*)(YAB + CW), (char*)lds, fk + 64 * ts, ts);
        }
        { int t3 = threadIdx.x; asm volatile("" : "+v"(t3)); const int lane = t3 & 63;
          const float* cw = args.in[I_CONVA];
          for (;;) {
            if (t3 == 0) slot[0] = (int)__hip_atomic_fetch_add((unsigned*)(ws + WS_UNITCTR + 128), 1u, __ATOMIC_RELAXED, __HIP_MEMORY_SCOPE_AGENT);
            __syncthreads();
            const int q = __builtin_amdgcn_readfirstlane(slot[0]);
            __syncthreads();
            if (q >= 344) break;
            if (q >= 256) {
                float s0[16], s1[16];
#pragma unroll
                for (int i = 0; i < 16; ++i) { const int k = 16 * lane + i; const float bb = bada[3 * D + k]; s0[i] = modacc[3 * D + k] + bb; s1[i] = modacc[NMOD + 3 * D + k] + bb; }
                for (int r = 0; r < 8; ++r) { const int n = 64 * (q - 256) + 8 * wave + r;
                    const v4u wa = *(const v4u*)(Wup_t + (size_t)n * D + 16 * lane), wb = *(const v4u*)(Wup_t + (size_t)n * D + 16 * lane + 8);
                    float a0 = 0.f, a1 = 0.f;
#pragma unroll
                    for (int i = 0; i < 4; ++i) { const float w0 = blo(wa[i]), w1 = bhi(wa[i]), w2 = blo(wb[i]), w3 = bhi(wb[i]);
                        a0 += w0 * s0[2 * i] + w1 * s0[2 * i + 1] + w2 * s0[8 + 2 * i] + w3 * s0[8 + 2 * i + 1];
                        a1 += w0 * s1[2 * i] + w1 * s1[2 * i + 1] + w2 * s1[8 + 2 * i] + w3 * s1[8 + 2 * i + 1]; }
                    a0 = wave_sum(a0); a1 = wave_sum(a1);
                    if (lane == 0) { cvec[n] = a0; cvec[NUP + n] = a1; } }
                continue;
            }
            const int m0 = 64 * q + 8 * wave;
            {
            const int t0 = m0 % T, col = lane * 8;
            float w0[8], w1[8], w2[8], p2[8], p1[8];
#pragma unroll
            for (int i = 0; i < 8; ++i) { w0[i] = cw[col + i]; w1[i] = cw[CW + col + i]; w2[i] = cw[2 * CW + col + i]; p2[i] = 0.f; p1[i] = 0.f; }
            if (t0 != 0) {
                const v4u a2 = *(const v4u*)(CC + (size_t)(m0 - 2) * CW + col), b2 = *(const v4u*)(CV + (size_t)(m0 - 2) * CW + col);
                const v4u a1 = *(const v4u*)(CC + (size_t)(m0 - 1) * CW + col), b1 = *(const v4u*)(CV + (size_t)(m0 - 1) * CW + col);
#pragma unroll
                for (int i = 0; i < 4; ++i) { p2[2 * i] = blo(a2[i]) * blo(b2[i]); p2[2 * i + 1] = bhi(a2[i]) * bhi(b2[i]); p1[2 * i] = blo(a1[i]) * blo(b1[i]); p1[2 * i + 1] = bhi(a1[i]) * bhi(b1[i]); }
            }
#pragma unroll
            for (int r = 0; r < 8; ++r) { const size_t m = (size_t)(m0 + r);
                const v4u a = *(const v4u*)(CC + m * CW + col), b = *(const v4u*)(CV + m * CW + col), cbv = *(const v4u*)(CB + m * CW + col);
                float cur[8], y[8];
#pragma unroll
                for (int i = 0; i < 4; ++i) { cur[2 * i] = blo(a[i]) * blo(b[i]); cur[2 * i + 1] = bhi(a[i]) * bhi(b[i]); }
#pragma unroll
                for (int i = 0; i < 8; ++i) { const float cbf = (i & 1) ? bhi(cbv[i >> 1]) : blo(cbv[i >> 1]); y[i] = cbf * (w0[i] * p2[i] + w1[i] * p1[i] + w2[i] * cur[i]); p2[i] = p1[i]; p1[i] = cur[i]; }
                v4u o; o.x = pk2(y[0], y[1]); o.y = pk2(y[2], y[3]); o.z = pk2(y[4], y[5]); o.w = pk2(y[6], y[7]);
                *(v4u*)(YAB + m * D + col) = o; }
            }
          }
        }
    }
    SEAM(3);
    if (IN(4)) {
        pg8::Gemm g{YAB, Wab_t, M, D, D}; pg8::StaticOrder S; S.init(M, D, G, bx);
        pg8::EpiMerged E{GA, GB, MERGED};
        pg8::gemm_phase<pg8::EpiMerged, pg8::StaticOrder, true, true>(ldsp, g, S, E);
    }
    SEAM(4);
    if (IN(5)) {
        pg8::Gemm g{MERGED, Wout_t, M, D, D}; pg8::StaticOrder S; S.init(M, D, G, bx);
        pg8::EpiRes<true> E{x, out, modacc + 2 * D, bada + 2 * D, T, NMOD, XN, args.in[I_N2G], modacc + 4 * D, bada + 4 * D, ssq, X1B};
        pg8::gemm_phase<pg8::EpiRes<true>, pg8::StaticOrder, true, true>(ldsp, g, S, E);
    }
    SEAM(5);
    if (IN(7)) {
        pg8::Gemm g{XN, Wup_t, M, NUP, D}; pg8::HaloOrder S; S.init(BATCH, NUP, G, bx);
        pg8::EpiUpConv E{ACT, ssq, cvec, args.in[I_CONVF], (LAS float*)(ldsp + 131072), 1.0f / D, RMS_EPS, DFF, NUP, T};
        pg8::gemm_phase<pg8::EpiUpConv, pg8::HaloOrder, true, true>(ldsp, g, S, E);
    }
    SEAM(7);
    if (IN(11)) {
        pg8::Gemm g{ACT, Wdn_t, M, D, DFF}; pg8::StaticOrder S; S.init(M, D, G, bx);
        pg8::EpiRes<false> E{nullptr, out, modacc + 5 * D, bada + 5 * D, T, NMOD, nullptr, nullptr, nullptr, nullptr, nullptr, X1B};
        pg8::gemm_phase<pg8::EpiRes<false>, pg8::StaticOrder, true, true>(ldsp, g, S, E);
    }
#undef IN
#undef SEAM
}

constexpr int LDS_BYTES = 147456;
extern "C" void kernel_launch(void* const* d_in, const int* in_sizes, int n_in, void* d_out, int out_size, void* d_ws, size_t ws_size, hipStream_t stream) {
    static int grid = 0;
    if (grid == 0) {
        if (n_in != 17 || out_size != M * D || ws_size < WS_END) { fprintf(stderr, "kernel_launch: unexpected shapes (n_in %d out %d ws %zu)\n", n_in, out_size, ws_size); grid = -1; return; }
        int dev = 0, cus = 0, per_cu = 0;
        (void)hipGetDevice(&dev); (void)hipDeviceGetAttribute(&cus, hipDeviceAttributeMultiprocessorCount, dev);
        (void)hipFuncSetAttribute((const void*)fwd_kernel, hipFuncAttributeMaxDynamicSharedMemorySize, LDS_BYTES);
        (void)hipOccupancyMaxActiveBlocksPerMultiprocessor(&per_cu, (const void*)fwd_kernel, NWAVES * 64, LDS_BYTES);
        if (per_cu < 1) per_cu = 1;
        (void)hipGetLastError();
        grid = cus * per_cu;
    }
    if (grid < 0) return;
    (void)hipMemsetAsync((char*)d_ws + WS_CTL, 0, CTL_ZERO_BYTES, stream);
    Args a{};
    for (int i = 0; i < 17; ++i) a.in[i] = (const float*)d_in[i];
    a.out = (float*)d_out; a.ws = (unsigned char*)d_ws;
#if MK_COOP
    a.ph_lo = 0; a.ph_hi = N_PHASES;
    void* kargs[] = {&a};
    hipError_t e = hipLaunchCooperativeKernel((const void*)fwd_kernel, dim3(grid), dim3(NWAVES * 64), kargs, LDS_BYTES, stream);
    if (e != hipSuccess) fprintf(stderr, "cooperative launch failed: %s (grid %d)\n", hipGetErrorString(e), grid);
#else
    for (int p = 0; p < N_PHASES; ++p) { a.ph_lo = p; a.ph_hi = p + 1; hipLaunchKernelGGL(fwd_kernel, dim3(grid), dim3(NWAVES * 64), LDS_BYTES, stream, a); }
#endif
}
```

```cpp
#include <hip/hip_runtime.h>
#include <cstdio>
#include <cstdint>
#include <hip/hip_cooperative_groups.h>
namespace pg8 {
#define PG8_LAS __attribute__((address_space(3)))
typedef unsigned short bf16_t;
typedef short bf16x8 __attribute__((ext_vector_type(8)));
typedef float f32x4 __attribute__((ext_vector_type(4)));
typedef unsigned u32x4 __attribute__((ext_vector_type(4)));
constexpr int BM = 256, BK = 64, HALF = 128, HTB = HALF * BK * 2  , STAGE_BYTES = 8 * HTB, NXCD = 8, WGM = 8;

__host__ __device__ __forceinline__ int lds_byte(int r, int c) { const int st = (r >> 4) * 2 + (c >> 5), rr = r & 15, cc = c & 31, ob = rr * 64 + cc * 2; return st * 1024 + (ob ^ (((ob >> 9) & 1) << 5)); }
__host__ __device__ __forceinline__ void stage_rc(int b, int& R, int& C) { const int st = b / 1024, sb = b % 1024, swz = sb ^ (((sb >> 9) & 1) << 5); R = (st >> 1) * 16 + swz / 64; C = (st & 1) * 32 + (swz % 64) / 2; }
__host__ __device__ __forceinline__ int perm32(int rho) { const int n = rho >> 4, i = rho & 15; return 8 * (i >> 2) + 4 * n + (i & 3); }

template <class E, class = void> struct epi_wants_sched { static constexpr bool value = false; };
template <class E> struct epi_wants_sched<E, decltype((void)E::SCHED)> { static constexpr bool value = true; };
struct Unit { int pm, pn; };
struct Gemm { const bf16_t* A; const bf16_t* Bt; int M, N, K; };

struct StaticOrder {
    int nM, nN, nwg, G, c;
    __host__ __device__ void init(int M, int N, int G_, int c_) { nM = M / BM; nN = N / BM; nwg = nM * nN; G = G_; c = c_; }
    __host__ __device__ bool next(int i, Unit& u) const {
        const long L = (long)i * G + c; if (L >= nwg) return false;
        int wgid = (int)L; { const int q = nwg / NXCD, r = nwg % NXCD, xcd = wgid % NXCD, off = wgid / NXCD; wgid = (xcd < r ? xcd * (q + 1) : r * (q + 1) + (xcd - r) * q) + off; }
        const int nig = WGM * nN, gid = wgid / nig, fm = gid * WGM, gsz = (nM - fm) < WGM ? (nM - fm) : WGM;
        u.pm = fm + ((wgid % nig) % gsz); u.pn = (wgid % nig) / gsz; return true;
    }
    __device__ __forceinline__ void a_ready(const Unit&) const {}
    __device__ __forceinline__ void done(const Unit&) const {}
    __host__ __device__ __forceinline__ int arow(const Unit& u) const { return u.pm * BM; }
};
struct HaloOrder : StaticOrder {
    static constexpr int SEQR = 8192, NT_ = 33;
    __host__ __device__ void init(int nseq, int N, int G_, int c_) { nM = nseq * NT_; nN = N / BM; nwg = nM * nN; G = G_; c = c_; }
    __host__ __device__ __forceinline__ int arow(const Unit& u) const { const int b = u.pm / NT_, j = u.pm % NT_; const int st = 254 * j; return b * SEQR + (st < SEQR - 256 ? st : SEQR - 256); }
    __host__ __device__ __forceinline__ int rlo(const Unit& u) const { const int j = u.pm % NT_; return j == 0 ? 0 : (j < NT_ - 1 ? 2 : (254 * (NT_ - 2) + 256) - (SEQR - 256)); }
};

__device__ __forceinline__ unsigned cvt_pk_bf16(float lo, float hi) { unsigned r; asm volatile("v_cvt_pk_bf16_f32 %0, %1, %2" : "=v"(r) : "v"(lo), "v"(hi)); return r; }
typedef float f32x2 __attribute__((ext_vector_type(2)));
__device__ __forceinline__ f32x2 gelu_pk(f32x2 v) {
    const f32x2 av = __builtin_elementwise_abs(v), d = av * 0.2316418882f + 1.0f;
    f32x2 t; t.x = __builtin_amdgcn_rcpf(d.x); t.y = __builtin_amdgcn_rcpf(d.y);
    f32x2 q = t * 0.5307027145f + (-0.7265760135f); q = q * t + 0.7107068705f; q = q * t + (-0.142248368f); q = q * t + 0.127414796f; q = q * t;
    const f32x2 s = (v * v) * (-0.72134752044f);
    f32x2 e; e.x = __builtin_amdgcn_exp2f(s.x); e.y = __builtin_amdgcn_exp2f(s.y);
    const f32x2 m = v * (q * e), r = v - m;
    f32x2 o; o.x = v.x < 0.f ? m.x : r.x; o.y = v.y < 0.f ? m.y : r.y; return o;
}

template <int ACT  > struct EpiBf16 {
    static constexpr bool PERM = true, AFTER_DRAIN = false, MID = false; static_assert(ACT == 0 || ACT == 1, "EpiBf16: ACT is 0 (none) or 1 (gelu_pk)");
    bf16_t* O; int ldc; const float* bias; int split_cols; size_t split_stride; float scale0;
    __device__ __forceinline__ void operator()(const f32x4 (&acc)[2][2][4][2], const Unit& u, int wr, int wc, int fr, int fq) const {
        const int row0 = u.pm * BM + wr * 64 + fr; int colt = u.pn * BM; bf16_t* base = O;
        float sc = 1.f; if (split_cols) { const int t = colt / split_cols; base += (size_t)t * split_stride; colt -= t * split_cols; if (t == 0) sc = scale0; }
        const int col0 = colt + wc * 32 + 8 * fq, bcol0 = u.pn * BM + wc * 32 + 8 * fq;
        f32x4 bv[2][2];
#pragma unroll
        for (int bj = 0; bj < 2; ++bj)
#pragma unroll
            for (int n = 0; n < 2; ++n) bv[bj][n] = bias ? *(const f32x4*)(bias + bcol0 + bj * HALF + 4 * n) : (f32x4){0.f, 0.f, 0.f, 0.f};
#pragma unroll
        for (int ai = 0; ai < 2; ++ai)
#pragma unroll
            for (int m = 0; m < 4; ++m) { bf16_t* rowp = base + (size_t)(row0 + ai * HALF + m * 16) * ldc + col0;
#pragma unroll
                for (int bj = 0; bj < 2; ++bj) { f32x4 v0 = acc[ai][bj][m][0] + bv[bj][0], v1 = acc[ai][bj][m][1] + bv[bj][1];
                    if (ACT == 1) { f32x2 a = gelu_pk((f32x2){v0[0], v0[1]}), b = gelu_pk((f32x2){v0[2], v0[3]}), c = gelu_pk((f32x2){v1[0], v1[1]}), d = gelu_pk((f32x2){v1[2], v1[3]});
                        v0 = (f32x4){a.x, a.y, b.x, b.y}; v1 = (f32x4){c.x, c.y, d.x, d.y}; }
                    v0 = v0 * sc; v1 = v1 * sc; u32x4 w; w.x = cvt_pk_bf16(v0[0], v0[1]); w.y = cvt_pk_bf16(v0[2], v0[3]); w.z = cvt_pk_bf16(v1[0], v1[1]); w.w = cvt_pk_bf16(v1[2], v1[3]);
                    *(u32x4*)(rowp + bj * HALF) = w; } }
    }
};
__device__ __forceinline__ float bf_lo(unsigned w) { return __uint_as_float(w << 16); }
__device__ __forceinline__ float bf_hi(unsigned w) { return __uint_as_float(w & 0xffff0000u); }
__device__ __forceinline__ float sigmoidf_(float x) { return __builtin_amdgcn_rcpf(1.0f + __expf(-x)); }
struct EpiIn {
    static constexpr bool PERM = true, AFTER_DRAIN = false, MID = false;
    bf16_t* CB; size_t st16, offGA, st32; const float* qg; long kdelta; float c2, eps;
    __device__ __forceinline__ void operator()(const f32x4 (&acc)[2][2][4][2], const Unit& u, int wr, int wc, int fr, int fq) const {
        const int pn = u.pn, row0 = u.pm * BM + wr * 64 + fr;
        if (pn >= 6 && pn < 10) {
            const bool isq = pn < 8; bf16_t* base = CB + (size_t)(pn >> 1) * st16; const float* g = qg + (isq ? 0L : kdelta); const float sc = isq ? c2 : 1.f;
            const int hcol = ((pn & 1) * 4 + wc) * 64;
            f32x4 gv[2][2];
#pragma unroll
            for (int bj = 0; bj < 2; ++bj)
#pragma unroll
                for (int n = 0; n < 2; ++n) gv[bj][n] = *(const f32x4*)(g + 32 * bj + 8 * fq + 4 * n);
#pragma unroll
            for (int ai = 0; ai < 2; ++ai)
#pragma unroll
                for (int m = 0; m < 4; ++m) {
                    float ss = 0.f;
#pragma unroll
                    for (int bj = 0; bj < 2; ++bj)
#pragma unroll
                        for (int n = 0; n < 2; ++n) { const f32x4 x = acc[ai][bj][m][n]; ss += (x[0] * x[0] + x[1] * x[1]) + (x[2] * x[2] + x[3] * x[3]); }
                    ss += __shfl_xor(ss, 16); ss += __shfl_xor(ss, 32);
                    const float inv = __builtin_amdgcn_rsqf(ss * (1.0f / 64.0f) + eps) * sc;
                    bf16_t* rowp = base + (size_t)(row0 + ai * HALF + m * 16) * 512 + hcol + 8 * fq;
#pragma unroll
                    for (int bj = 0; bj < 2; ++bj) { const f32x4 v0 = acc[ai][bj][m][0] * inv * gv[bj][0], v1 = acc[ai][bj][m][1] * inv * gv[bj][1];
                        u32x4 w; w.x = cvt_pk_bf16(v0[0], v0[1]); w.y = cvt_pk_bf16(v0[2], v0[3]); w.z = cvt_pk_bf16(v1[0], v1[1]); w.w = cvt_pk_bf16(v1[2], v1[3]);
                        *(u32x4*)(rowp + 32 * bj) = w; }
                }
        } else {
            bf16_t* base; int ldc, colt; bool sig = false;
            if (pn < 12) { base = CB + (size_t)(pn >> 1) * st16; ldc = 512; colt = (pn & 1) * 256; }
            else { base = CB + offGA + (size_t)((pn - 12) >> 2) * st32; ldc = 1024; colt = ((pn - 12) & 3) * 256; sig = true; }
            const int col0 = colt + wc * 32 + 8 * fq;
#pragma unroll
            for (int ai = 0; ai < 2; ++ai)
#pragma unroll
                for (int m = 0; m < 4; ++m) { bf16_t* rowp = base + (size_t)(row0 + ai * HALF + m * 16) * ldc + col0;
#pragma unroll
                    for (int bj = 0; bj < 2; ++bj) { f32x4 v0 = acc[ai][bj][m][0], v1 = acc[ai][bj][m][1];
                        if (sig) { v0 = (f32x4){sigmoidf_(v0[0]), sigmoidf_(v0[1]), sigmoidf_(v0[2]), sigmoidf_(v0[3])}; v1 = (f32x4){sigmoidf_(v1[0]), sigmoidf_(v1[1]), sigmoidf_(v1[2]), sigmoidf_(v1[3])}; }
                        u32x4 w; w.x = cvt_pk_bf16(v0[0], v0[1]); w.y = cvt_pk_bf16(v0[2], v0[3]); w.z = cvt_pk_bf16(v1[0], v1[1]); w.w = cvt_pk_bf16(v1[2], v1[3]);
                        *(u32x4*)(rowp + bj * HALF) = w; } }
        }
    }
};
struct EpiMerged {
    static constexpr bool PERM = true, AFTER_DRAIN = false, MID = true;
    const bf16_t *GA, *GB; bf16_t* O;
    __device__ __forceinline__ void mid(f32x4 (&acc)[2][2][4][2], const Unit& u, int wr, int wc, int fr, int fq) const {
        int row0 = u.pm * BM + wr * 64 + fr, col0 = u.pn * BM + wc * 32 + 8 * fq;
        asm volatile("" : "+v"(row0), "+v"(col0));
#pragma unroll
        for (int ai = 0; ai < 2; ++ai)
#pragma unroll
            for (int m = 0; m < 4; ++m) { const size_t off = (size_t)(row0 + ai * HALF + m * 16) * 1024 + col0;
#pragma unroll
                for (int bj = 0; bj < 2; ++bj) { const u32x4 a = *(const u32x4*)(GA + off + bj * HALF), b = *(const u32x4*)(GB + off + bj * HALF);
                    f32x4 r0, r1;
                    r0[0] = bf_lo(a.x) * __builtin_amdgcn_rcpf(bf_lo(b.x)); r0[1] = bf_hi(a.x) * __builtin_amdgcn_rcpf(bf_hi(b.x));
                    r0[2] = bf_lo(a.y) * __builtin_amdgcn_rcpf(bf_lo(b.y)); r0[3] = bf_hi(a.y) * __builtin_amdgcn_rcpf(bf_hi(b.y));
                    r1[0] = bf_lo(a.z) * __builtin_amdgcn_rcpf(bf_lo(b.z)); r1[1] = bf_hi(a.z) * __builtin_amdgcn_rcpf(bf_hi(b.z));
                    r1[2] = bf_lo(a.w) * __builtin_amdgcn_rcpf(bf_lo(b.w)); r1[3] = bf_hi(a.w) * __builtin_amdgcn_rcpf(bf_hi(b.w));
                    acc[ai][bj][m][0] *= r0; acc[ai][bj][m][1] *= r1; asm volatile("" ::: "memory"); } }
    }
    __device__ __forceinline__ void operator()(const f32x4 (&acc)[2][2][4][2], const Unit& u, int wr, int wc, int fr, int fq) const {
        const int row0 = u.pm * BM + wr * 64 + fr, col0 = u.pn * BM + wc * 32 + 8 * fq;
#pragma unroll
        for (int ai = 0; ai < 2; ++ai)
#pragma unroll
            for (int m = 0; m < 4; ++m) { const size_t off = (size_t)(row0 + ai * HALF + m * 16) * 1024 + col0;
#pragma unroll
                for (int bj = 0; bj < 2; ++bj) { const u32x4 b = *(const u32x4*)(GB + off + bj * HALF);
                    const f32x4 v0 = acc[ai][bj][m][0] * (f32x4){bf_lo(b.x), bf_hi(b.x), bf_lo(b.y), bf_hi(b.y)}, v1 = acc[ai][bj][m][1] * (f32x4){bf_lo(b.z), bf_hi(b.z), bf_lo(b.w), bf_hi(b.w)};
                    u32x4 w; w.x = cvt_pk_bf16(v0[0], v0[1]); w.y = cvt_pk_bf16(v0[2], v0[3]); w.z = cvt_pk_bf16(v1[0], v1[1]); w.w = cvt_pk_bf16(v1[2], v1[3]);
                    *(u32x4*)(O + off + bj * HALF) = w; asm volatile("" ::: "memory"); } }
    }
};
template <bool NORM> struct EpiRes {
    static constexpr bool PERM = true, AFTER_DRAIN = false, MID = false;
    const float* base; float* out; const float* gacc; const float* gbias; int rows_per_batch, gstride;
    bf16_t* xn; const float* ng; const float* scacc; const float* scbias; float* ssq; bf16_t* x1b;
    __device__ __forceinline__ void operator()(const f32x4 (&acc)[2][2][4][2], const Unit& u, int wr, int wc, int fr, int fq) const {
        const int b = (u.pm * BM) / rows_per_batch, row0 = u.pm * BM + wr * 64 + fr, col0 = u.pn * BM + wc * 32 + 8 * fq;
        f32x4 gv[2][2], av[2][2];
#pragma unroll
        for (int bj = 0; bj < 2; ++bj)
#pragma unroll
            for (int n = 0; n < 2; ++n) { const int c = col0 + bj * HALF + n * 4;
                gv[bj][n] = *(const f32x4*)(gacc + (size_t)b * gstride + c) + *(const f32x4*)(gbias + c);
                if (NORM) av[bj][n] = *(const f32x4*)(ng + c) * (*(const f32x4*)(scacc + (size_t)b * gstride + c) + *(const f32x4*)(scbias + c) + 1.0f); }
#pragma unroll
        for (int ai = 0; ai < 2; ++ai)
#pragma unroll
            for (int m = 0; m < 4; ++m) { const int row = row0 + ai * HALF + m * 16; const size_t off = (size_t)row * 1024 + col0; float ss = 0.f;
#pragma unroll
                for (int bj = 0; bj < 2; ++bj) { f32x4 o[2];
                    if constexpr (NORM) {
#pragma unroll
                        for (int n = 0; n < 2; ++n) { const f32x4 bs = __builtin_nontemporal_load((const f32x4*)(base + off + bj * HALF + n * 4)); o[n] = bs + gv[bj][n] * acc[ai][bj][m][n]; }
                        u32x4 xw; xw.x = cvt_pk_bf16(o[0][0], o[0][1]); xw.y = cvt_pk_bf16(o[0][2], o[0][3]); xw.z = cvt_pk_bf16(o[1][0], o[1][1]); xw.w = cvt_pk_bf16(o[1][2], o[1][3]);
                        *(u32x4*)(x1b + off + bj * HALF) = xw;
                    } else {
                        const u32x4 xb = __builtin_nontemporal_load((const u32x4*)(x1b + off + bj * HALF));
                        o[0] = (f32x4){bf_lo(xb.x), bf_hi(xb.x), bf_lo(xb.y), bf_hi(xb.y)} + gv[bj][0] * acc[ai][bj][m][0]; o[1] = (f32x4){bf_lo(xb.z), bf_hi(xb.z), bf_lo(xb.w), bf_hi(xb.w)} + gv[bj][1] * acc[ai][bj][m][1];
#pragma unroll
                        for (int n = 0; n < 2; ++n) __builtin_nontemporal_store(o[n], (f32x4*)(out + off + bj * HALF + n * 4));
                    }
                    if (NORM) { ss += (o[0][0] * o[0][0] + o[0][1] * o[0][1]) + (o[0][2] * o[0][2] + o[0][3] * o[0][3]) + (o[1][0] * o[1][0] + o[1][1] * o[1][1]) + (o[1][2] * o[1][2] + o[1][3] * o[1][3]);
                        const f32x4 h0 = o[0] * av[bj][0], h1 = o[1] * av[bj][1];
                        u32x4 w; w.x = cvt_pk_bf16(h0[0], h0[1]); w.y = cvt_pk_bf16(h0[2], h0[3]); w.z = cvt_pk_bf16(h1[0], h1[1]); w.w = cvt_pk_bf16(h1[2], h1[3]);
                        *(u32x4*)(xn + off + bj * HALF) = w; } }
                if (NORM) { ss += __shfl_xor(ss, 16); ss += __shfl_xor(ss, 32); if (fq == 0) atomicAdd(ssq + row, ss); }
                if (m & 1) asm volatile("" ::: "memory"); }
    }
};
__device__ __forceinline__ float dpp_ror1(float x) { return __builtin_bit_cast(float, __builtin_amdgcn_update_dpp(0, __builtin_bit_cast(int, x), 0x121, 0xf, 0xf, false)); }
__device__ __forceinline__ float dpp_ror2(float x) { return __builtin_bit_cast(float, __builtin_amdgcn_update_dpp(0, __builtin_bit_cast(int, x), 0x122, 0xf, 0xf, false)); }
struct EpiUpConv {
    static constexpr bool PERM = true, AFTER_DRAIN = false, MID = false, SCHED = true;
    bf16_t* ACT; const float* ssq; const float* cvec; const float* cw; PG8_LAS float* ex; float invk, eps; int dff, nup, rows_per_batch;
    template <class Sched> __device__ __forceinline__ void run(f32x4 (&acc)[2][2][4][2], const Unit& u, const Sched& S, int wr, int wc, int fr, int fq) const {
        const int arow = S.arow(u), rlo = S.rlo(u), b = arow / rows_per_batch, wid = wr * 4 + wc;
        const int slot0 = u.pn * BM + wc * 32 + 8 * fq, ch0 = u.pn * HALF + wc * 32 + 8 * fq;
        { f32x4 cv[2][2];
#pragma unroll
          for (int bj = 0; bj < 2; ++bj)
#pragma unroll
              for (int n = 0; n < 2; ++n) cv[bj][n] = *(const f32x4*)(cvec + (size_t)b * nup + slot0 + bj * HALF + n * 4);
#pragma unroll
          for (int ai = 0; ai < 2; ++ai)
#pragma unroll
              for (int m = 0; m < 4; ++m) { const float inv = __builtin_amdgcn_rsqf(ssq[arow + ai * HALF + wr * 64 + m * 16 + fr] * invk + eps);
#pragma unroll
                  for (int bj = 0; bj < 2; ++bj)
#pragma unroll
                      for (int n = 0; n < 2; ++n) acc[ai][bj][m][n] = acc[ai][bj][m][n] * inv + cv[bj][n]; } }
        if (fr >= 14) {
#pragma unroll
            for (int ai = 0; ai < 2; ++ai) { PG8_LAS f32x4* d = (PG8_LAS f32x4*)(ex + ((((wid * 2 + ai) * 2 + (fr - 14)) * 4 + fq) * 16));
                d[0] = acc[ai][0][3][0]; d[1] = acc[ai][0][3][1]; d[2] = acc[ai][1][3][0]; d[3] = acc[ai][1][3][1]; }
        }
        asm volatile("s_waitcnt lgkmcnt(0)" ::: "memory"); __builtin_amdgcn_s_barrier(); asm volatile("" ::: "memory");
        typedef unsigned u32x2 __attribute__((ext_vector_type(2)));
#pragma unroll
        for (int n = 0; n < 2; ++n) {
            f32x4 w[3][2];
#pragma unroll
            for (int k = 0; k < 3; ++k)
#pragma unroll
                for (int bj = 0; bj < 2; ++bj) w[k][bj] = *(const f32x4*)(cw + (size_t)k * nup + bj * dff + ch0 + n * 4);
#pragma unroll
            for (int ai = 0; ai < 2; ++ai) {
                f32x4 p1[2], p2[2];
                if (wr == 1 || ai == 1) { const int sw = wr == 1 ? wid - 4 : wid + 4, sa = wr == 1 ? ai : 0;
                    const PG8_LAS f32x4* e1 = (const PG8_LAS f32x4*)(ex + ((((sw * 2 + sa) * 2 + 1) * 4 + fq) * 16)); const PG8_LAS f32x4* e2 = (const PG8_LAS f32x4*)(ex + ((((sw * 2 + sa) * 2 + 0) * 4 + fq) * 16));
#pragma unroll
                    for (int bj = 0; bj < 2; ++bj) { const f32x4 r1 = e1[bj * 2 + n], r2 = e2[bj * 2 + n]; p1[bj] = r1; p2[bj] = fr == 0 ? r2 : r1; }
                } else {
#pragma unroll
                    for (int bj = 0; bj < 2; ++bj) { p1[bj] = (f32x4){0.f, 0.f, 0.f, 0.f}; p2[bj] = (f32x4){0.f, 0.f, 0.f, 0.f}; }
                }
#pragma unroll
                for (int m = 0; m < 4; ++m) {
                    f32x4 cvv[2];
#pragma unroll
                    for (int bj = 0; bj < 2; ++bj) { const f32x4 x = acc[ai][bj][m][n]; f32x4 t1, t2, q1, q2;
#pragma unroll
                        for (int i = 0; i < 4; ++i) { t1[i] = dpp_ror1(x[i]); t2[i] = dpp_ror2(x[i]); q1[i] = fr >= 1 ? t1[i] : p1[bj][i]; q2[i] = fr >= 2 ? t2[i] : p2[bj][i]; }
                        cvv[bj] = w[0][bj] * q2 + w[1][bj] * q1 + w[2][bj] * x;
                        p1[bj] = t1; p2[bj] = t2; }
                    const int lr = ai * HALF + wr * 64 + m * 16 + fr;
                    f32x4 o;
#pragma unroll
                    for (int i = 0; i < 4; ++i) { const float g0 = cvv[0][i]; o[i] = g0 * __builtin_amdgcn_rcpf(1.0f + __expf(-g0)) * cvv[1][i]; }
                    if (lr >= rlo) { u32x2 wv; wv.x = cvt_pk_bf16(o[0], o[1]); wv.y = cvt_pk_bf16(o[2], o[3]); *(u32x2*)(ACT + (size_t)(arow + lr) * dff + ch0 + n * 4) = wv; }
                }
            }
        }
    }
};
struct EpiUp {
    static constexpr bool PERM = true, AFTER_DRAIN = false, MID = false;
    bf16_t* O; int ldc; const float* ssq; const float* cvec; float invk, eps;
    __device__ __forceinline__ void operator()(const f32x4 (&acc)[2][2][4][2], const Unit& u, int wr, int wc, int fr, int fq) const {
        const int row0 = u.pm * BM + wr * 64 + fr, col0 = u.pn * BM + wc * 32 + 8 * fq;
        f32x4 cv[2][2];
#pragma unroll
        for (int bj = 0; bj < 2; ++bj)
#pragma unroll
            for (int n = 0; n < 2; ++n) cv[bj][n] = *(const f32x4*)(cvec + col0 + bj * HALF + n * 4);
#pragma unroll
        for (int ai = 0; ai < 2; ++ai)
#pragma unroll
            for (int m = 0; m < 4; ++m) { const int row = row0 + ai * HALF + m * 16; const float inv = __builtin_amdgcn_rsqf(ssq[row] * invk + eps);
                bf16_t* rowp = O + (size_t)row * ldc + col0;
#pragma unroll
                for (int bj = 0; bj < 2; ++bj) { const f32x4 v0 = acc[ai][bj][m][0] * inv + cv[bj][0], v1 = acc[ai][bj][m][1] * inv + cv[bj][1];
                    u32x4 w; w.x = cvt_pk_bf16(v0[0], v0[1]); w.y = cvt_pk_bf16(v0[2], v0[3]); w.z = cvt_pk_bf16(v1[0], v1[1]); w.w = cvt_pk_bf16(v1[2], v1[3]);
                    *(u32x4*)(rowp + bj * HALF) = w; } }
    }
};
template <class Epi, class Sched, bool ALIGN_EPI = false, bool SP2 = false>
__device__ __forceinline__ void gemm_phase(PG8_LAS unsigned char* lds, const Gemm g, const Sched& S, const Epi& E) {
    const int tid = threadIdx.x, wid = __builtin_amdgcn_readfirstlane(tid >> 6), lane = tid & 63, wr = wid >> 2, wc = wid & 3, fr = lane & 15, fq = lane >> 4;
    const int K = g.K, nt = K / BK;
    unsigned voffA[2], voffB[2];
#pragma unroll
    for (int i = 0; i < 2; ++i) { int R, C; stage_rc(tid * 16 + i * 8192, R, C); const int Rb = Epi::PERM ? ((R & ~31) + perm32(R & 31)) : R;
        voffA[i] = (unsigned)(R * K + C) * 2u; voffB[i] = (unsigned)(Rb * K + C) * 2u; }
    const size_t kstep = (size_t)(BK * 2);
    const size_t hstep = (size_t)HALF * K * 2;
    const size_t tstep = 2 * hstep;
    const unsigned ldsw = (unsigned)wid * 1024u;
    const int aoff = lds_byte(wr * 64 + fr, fq * 8), boff = lds_byte(wc * 32 + fr, fq * 8);
#define PG8_SA(b, h) (((b) * 2 + (h)) * HTB)
#define PG8_SB(b, h) ((4 + (b) * 2 + (h)) * HTB)
#define PG8_STAGE(bufoff, gbase, voff) do { _Pragma("unroll") for (int _i = 0; _i < 2; ++_i) \
        __builtin_amdgcn_global_load_lds((const unsigned*)((const char*)(gbase) + (voff)[_i]), (PG8_LAS unsigned*)(lds + (bufoff) + ldsw + _i * 8192), 16, 0, 0); } while (0)
#define PG8_LDA(dst, b, h) do { _Pragma("unroll") for (int m = 0; m < 4; ++m) _Pragma("unroll") for (int k = 0; k < 2; ++k) dst[m][k] = *(const PG8_LAS bf16x8*)(lds + PG8_SA(b, h) + aoff + m * 2048 + k * 1024); } while (0)
#define PG8_LDB(dst, b, h) do { _Pragma("unroll") for (int n = 0; n < 2; ++n) _Pragma("unroll") for (int k = 0; k < 2; ++k) dst[n][k] = *(const PG8_LAS bf16x8*)(lds + PG8_SB(b, h) + boff + n * 2048 + k * 1024); } while (0)
#define PG8_MMA(ai, bj, At, Bt) do { __builtin_amdgcn_s_setprio(1); _Pragma("unroll") for (int m = 0; m < 4; ++m) _Pragma("unroll") for (int n = 0; n < 2; ++n) _Pragma("unroll") for (int k = 0; k < 2; ++k) \
        acc[ai][bj][m][n] = __builtin_amdgcn_mfma_f32_16x16x32_bf16(Bt[n][k], At[m][k], acc[ai][bj][m][n], 0, 0, 0); __builtin_amdgcn_s_setprio(0); } while (0)
#define PG8_WAIT_V(n) asm volatile("s_waitcnt vmcnt(" #n ")" ::: "memory")
#define PG8_WAIT_L(n) asm volatile("s_waitcnt lgkmcnt(" #n ")" ::: "memory")
#define PG8_BAR __builtin_amdgcn_s_barrier()
#define PG8_SCHED __builtin_amdgcn_sched_barrier(0)
    Unit cur, nxt; int ui = 0;
    if (!S.next(0, cur)) return;
    f32x4 acc[2][2][4][2];
#pragma unroll
    for (int a = 0; a < 2; ++a)
#pragma unroll
        for (int b = 0; b < 2; ++b)
#pragma unroll
            for (int m = 0; m < 4; ++m)
#pragma unroll
                for (int n = 0; n < 2; ++n) acc[a][b][m][n] = (f32x4){0.f, 0.f, 0.f, 0.f};
    bf16x8 At[4][2], B0[2][2], B1[2][2];
    const size_t rstep = (size_t)K * 2;
    const char* cA = (const char*)g.A + (size_t)S.arow(cur) * rstep; const char* cB = (const char*)g.Bt + (size_t)cur.pn * tstep;
    S.a_ready(cur);
    if constexpr (SP2) {
        PG8_STAGE(PG8_SB(0, 0), cB, voffB); PG8_STAGE(PG8_SB(0, 1), cB + hstep, voffB); PG8_STAGE(PG8_SA(0, 0), cA, voffA); PG8_STAGE(PG8_SA(0, 1), cA + hstep, voffA);
        if (wr == 1) PG8_BAR;
        PG8_WAIT_V(2); PG8_BAR;
        PG8_STAGE(PG8_SB(1, 0), cB + kstep, voffB); PG8_STAGE(PG8_SA(1, 0), cA + kstep, voffA); PG8_STAGE(PG8_SB(1, 1), cB + hstep + kstep, voffB);
        PG8_WAIT_V(6); PG8_BAR;
    } else {
        PG8_STAGE(PG8_SB(0, 0), cB, voffB); PG8_STAGE(PG8_SA(0, 0), cA, voffA); PG8_STAGE(PG8_SB(0, 1), cB + hstep, voffB); PG8_STAGE(PG8_SA(0, 1), cA + hstep, voffA);
        if (wr == 1) PG8_BAR;
        PG8_WAIT_V(4); PG8_BAR;
        PG8_STAGE(PG8_SB(1, 0), cB + kstep, voffB); PG8_STAGE(PG8_SA(1, 0), cA + kstep, voffA); PG8_STAGE(PG8_SB(1, 1), cB + hstep + kstep, voffB);
        PG8_WAIT_V(6); PG8_BAR;
    }
    for (;;) {
        const bool has_next = S.next(ui + 1, nxt);
        const char* nA = has_next ? (const char*)g.A + (size_t)S.arow(nxt) * rstep : cA; const char* nB = has_next ? (const char*)g.Bt + (size_t)nxt.pn * tstep : cB;
        for (int t = 0; t < nt; t += 2) {
            const bool last = (t == nt - 2);
            if constexpr (Epi::MID) { if (t == (nt >> 1)) E.mid(acc, cur, wr, wc, fr, fq); }
            const char* a1 = cA + (size_t)(t + 1) * kstep;
            const char* a2 = last ? nA : cA + (size_t)(t + 2) * kstep; const char* b2 = last ? nB : cB + (size_t)(t + 2) * kstep;
            const char* a3 = a2 + kstep; const char* b3 = b2 + kstep;
            if (last && has_next) S.a_ready(nxt);
            if constexpr (SP2) {
            PG8_LDB(B0, 0, 0); PG8_LDB(B1, 0, 1); PG8_SCHED; PG8_LDA(At, 0, 0); PG8_STAGE(PG8_SA(1, 1), a1 + hstep, voffA);
            PG8_WAIT_V(8); PG8_WAIT_L(0); PG8_BAR; PG8_MMA(0, 0, At, B0); PG8_MMA(0, 1, At, B1); PG8_BAR; PG8_SCHED;
            PG8_LDA(At, 0, 1); PG8_STAGE(PG8_SB(0, 0), b2, voffB); PG8_STAGE(PG8_SB(0, 1), b2 + hstep, voffB); PG8_STAGE(PG8_SA(0, 0), a2, voffA);
            PG8_WAIT_V(8); PG8_WAIT_L(0); PG8_BAR; PG8_MMA(1, 0, At, B0); PG8_MMA(1, 1, At, B1); PG8_BAR; PG8_SCHED;
            PG8_LDB(B0, 1, 0); PG8_LDB(B1, 1, 1); PG8_SCHED; PG8_LDA(At, 1, 0); PG8_STAGE(PG8_SA(0, 1), a2 + hstep, voffA);
            PG8_WAIT_V(8); PG8_WAIT_L(0); PG8_BAR; PG8_MMA(0, 0, At, B0); PG8_MMA(0, 1, At, B1); PG8_BAR; PG8_SCHED;
            PG8_LDA(At, 1, 1); PG8_STAGE(PG8_SB(1, 0), b3, voffB); PG8_STAGE(PG8_SB(1, 1), b3 + hstep, voffB); PG8_STAGE(PG8_SA(1, 0), a3, voffA);
            PG8_WAIT_V(8); PG8_WAIT_L(0); PG8_BAR; PG8_MMA(1, 0, At, B0); PG8_MMA(1, 1, At, B1); PG8_BAR; PG8_SCHED;
            } else {
            PG8_LDB(B0, 0, 0); PG8_SCHED; PG8_LDA(At, 0, 0); PG8_STAGE(PG8_SA(1, 1), a1 + hstep, voffA);
            PG8_WAIT_L(8); PG8_BAR; PG8_WAIT_L(0); PG8_MMA(0, 0, At, B0); PG8_BAR; PG8_SCHED;
            PG8_LDB(B1, 0, 1); PG8_STAGE(PG8_SB(0, 0), b2, voffB);
            PG8_BAR; PG8_WAIT_L(0); PG8_MMA(0, 1, At, B1); PG8_BAR;
            PG8_LDA(At, 0, 1); PG8_STAGE(PG8_SA(0, 0), a2, voffA);
            PG8_BAR; PG8_WAIT_L(0); PG8_MMA(1, 0, At, B0); PG8_BAR; PG8_SCHED;
            PG8_STAGE(PG8_SB(0, 1), b2 + hstep, voffB);
            PG8_WAIT_V(6); PG8_BAR; PG8_MMA(1, 1, At, B1); PG8_BAR;
            PG8_LDB(B0, 1, 0); PG8_SCHED; PG8_LDA(At, 1, 0); PG8_STAGE(PG8_SA(0, 1), a2 + hstep, voffA);
            PG8_WAIT_L(8); PG8_BAR; PG8_WAIT_L(0); PG8_MMA(0, 0, At, B0); PG8_BAR; PG8_SCHED;
            PG8_LDB(B1, 1, 1); PG8_STAGE(PG8_SB(1, 0), b3, voffB);
            PG8_BAR; PG8_WAIT_L(0); PG8_MMA(0, 1, At, B1); PG8_BAR;
            PG8_LDA(At, 1, 1); PG8_STAGE(PG8_SA(1, 0), a3, voffA);
            PG8_BAR; PG8_WAIT_L(0); PG8_MMA(1, 0, At, B0); PG8_BAR; PG8_SCHED;
            PG8_STAGE(PG8_SB(1, 1), b3 + hstep, voffB);
            PG8_WAIT_V(6); PG8_BAR; PG8_MMA(1, 1, At, B1); PG8_BAR;
            }
        }
        if constexpr (ALIGN_EPI) { if (wr == 0) PG8_BAR; }
        if constexpr (!Epi::AFTER_DRAIN) { if constexpr (epi_wants_sched<Epi>::value) E.run(acc, cur, S, wr, wc, fr, fq); else E(acc, cur, wr, wc, fr, fq); S.done(cur); }
        if (!has_next) break;
#pragma unroll
        for (int a = 0; a < 2; ++a)
#pragma unroll
            for (int b = 0; b < 2; ++b)
#pragma unroll
                for (int m = 0; m < 4; ++m)
#pragma unroll
                    for (int n = 0; n < 2; ++n) acc[a][b][m][n] = (f32x4){0.f, 0.f, 0.f, 0.f};
        cur = nxt; cA = nA; cB = nB; ++ui;
        if constexpr (ALIGN_EPI) { if (wr == 1) PG8_BAR; }
    }
    PG8_WAIT_V(0);
    if constexpr (!ALIGN_EPI) { if (wr == 0) PG8_BAR; }
    PG8_BAR;
    if constexpr (Epi::AFTER_DRAIN) { E.fused(acc, cur, wr, wc, fr, fq, lds, wid, lane); S.done(cur); }
#undef PG8_SA
#undef PG8_SB
#undef PG8_STAGE
#undef PG8_LDA
#undef PG8_LDB
#undef PG8_MMA
#undef PG8_WAIT_V
#undef PG8_WAIT_L
#undef PG8_BAR
#undef PG8_SCHED
}
}

#ifndef PG8_SP2
#define PG8_SP2 true
#endif
#ifndef PG8_ALIGN
#define PG8_ALIGN true
#endif
#include <hip/hip_bf16.h>
#include <cmath>
namespace attn_body {
using bf16=__hip_bfloat16;
using bf16x8=__attribute__((ext_vector_type(8)))short;
using s16x4=__attribute__((ext_vector_type(4)))short;
using f32x16=__attribute__((ext_vector_type(16)))float;
using u32x4=__attribute__((ext_vector_type(4)))unsigned;
constexpr int BATCH=2,NHEAD=8,SEQ=8192,D=64,DM=NHEAD*D,OPITCH=1024;
constexpr int NW=8,QBLK=32,QB=QBLK*NW,KVBLK=64,NQB=SEQ/QB;
constexpr int ATTN_PITCH=DM, ATTN_UNIT_ROWS=QB;
__device__ __forceinline__ int crow(int r,int hi){return (r&3)+8*(r>>2)+4*hi;}
#define SBAR() __builtin_amdgcn_sched_barrier(0)
__device__ __forceinline__ void cmask(f32x16&p0,f32x16&p1,int jb,int qrel,int hi){
  const float NEG=-INFINITY; int kb=64*jb+4*hi;
  #pragma unroll
  for(int r=0;r<16;++r){int kv=kb+(r&3)+8*(r>>2); if(kv>qrel)p0[r]=NEG; if(kv+32>qrel)p1[r]=NEG;}
}

constexpr int NSLOT=3, SLOTB=8192;
constexpr int LDS_K=0, LDS_V=NSLOT*SLOTB, LDS_WS=2*NSLOT*SLOTB, LDS_OST=LDS_WS+NW*64*4, LDS_BYTES=LDS_OST+NW*4096;
constexpr float C2=0.125f*1.4426950408889634f;
__device__ __forceinline__ void glds16(const void*sbase,unsigned voff,unsigned lds_dst){unsigned keep;
  asm volatile("s_mov_b32 %0, m0\n\ts_mov_b32 m0, %3\n\ts_nop 0\n\tglobal_load_lds_dwordx4 %1, %2\n\ts_mov_b32 m0, %0":"=&s"(keep):"v"(voff),"s"(sbase),"s"(lds_dst):"memory");}
__device__ __forceinline__ float max3f(float a,float b,float c){float r;asm("v_max3_f32 %0, %1, %2, %3":"=v"(r):"v"(a),"v"(b),"v"(c));return r;}
__device__ __forceinline__ float max2f(float a,float b){float r;asm("v_max_f32_e32 %0, %1, %2":"=v"(r):"v"(a),"v"(b));return r;}
__device__ __forceinline__ float fadd_s(float a,float b){float r;asm("v_add_f32_e32 %0, %1, %2":"=v"(r):"v"(a),"v"(b));return r;}
__device__ __forceinline__ float fsub_s(float a,float b){float r;asm("v_sub_f32_e32 %0, %1, %2":"=v"(r):"v"(a),"v"(b));return r;}
typedef float f32x2_t __attribute__((ext_vector_type(2))); typedef __bf16 bf16x2_t __attribute__((ext_vector_type(2)));
__device__ __forceinline__ unsigned cvtpk_s(float lo,float hi){f32x2_t v={lo,hi};bf16x2_t b=__builtin_convertvector(v,bf16x2_t);return __builtin_bit_cast(unsigned,b);}
#define WAIT_BAR(N) asm volatile("s_waitcnt vmcnt(" #N ") lgkmcnt(0)\n\ts_barrier":::"memory")

__device__ __forceinline__ void qkt(f32x16&p0,f32x16&p1,const char*Kslot,const bf16x8*qr,int r32,int hi){
  const char*kb=Kslot+hi*1024+r32*16;
  #pragma unroll
  for(int d0=0;d0<4;++d0){
    const bf16x8 b0=*reinterpret_cast<const bf16x8*>(kb+d0*2048);
    const bf16x8 b1=*reinterpret_cast<const bf16x8*>(kb+d0*2048+512);
    {p0=__builtin_amdgcn_mfma_f32_32x32x16_bf16(b0,qr[d0],p0,0,0,0);p1=__builtin_amdgcn_mfma_f32_32x32x16_bf16(b1,qr[d0],p1,0,0,0);}}
}
typedef __attribute__((address_space(3))) const char* lds_cptr;
typedef short v4i16_t __attribute__((ext_vector_type(4)));
__device__ __forceinline__ void kload8(bf16x8*kf,lds_cptr kp){
  kf[0]=*(const __attribute__((address_space(3))) bf16x8*)(kp);      kf[1]=*(const __attribute__((address_space(3))) bf16x8*)(kp+512);
  kf[2]=*(const __attribute__((address_space(3))) bf16x8*)(kp+2048); kf[3]=*(const __attribute__((address_space(3))) bf16x8*)(kp+2560);
  kf[4]=*(const __attribute__((address_space(3))) bf16x8*)(kp+4096); kf[5]=*(const __attribute__((address_space(3))) bf16x8*)(kp+4608);
  kf[6]=*(const __attribute__((address_space(3))) bf16x8*)(kp+6144); kf[7]=*(const __attribute__((address_space(3))) bf16x8*)(kp+6656);
}
__device__ __forceinline__ void kload2(bf16x8*kf,lds_cptr kp,int j){ kf[2*j]=*(const __attribute__((address_space(3))) bf16x8*)(kp+j*2048); kf[2*j+1]=*(const __attribute__((address_space(3))) bf16x8*)(kp+j*2048+512); }
__device__ __forceinline__ s16x4 vtr(lds_cptr p){ return __builtin_bit_cast(s16x4,__builtin_amdgcn_ds_read_tr16_b64_v4i16((__attribute__((address_space(3))) v4i16_t*)p)); }
__device__ __forceinline__ float rowmax(const f32x16&p0,const f32x16&p1){
  float a=max3f(p0[0],p0[1],p1[0]),b=max3f(p0[2],p0[3],p1[1]);a=max3f(a,p1[2],p1[3]);
  #pragma unroll
  for(int r=4;r<16;r+=4){a=max3f(a,p0[r],p0[r+1]);b=max3f(b,p0[r+2],p0[r+3]);a=max3f(a,p1[r],p1[r+1]);b=max3f(b,p1[r+2],p1[r+3]);}
  const float m=max2f(a,b);
  auto rr=__builtin_amdgcn_permlane32_swap(__float_as_uint(m),__float_as_uint(m),false,false);
  return max2f(__uint_as_float(rr[0]),__uint_as_float(rr[1]));
}
__device__ __forceinline__ void pv(f32x16*o,int vb,bf16x8 pa0,bf16x8 pa1,bf16x8 pa2,bf16x8 pa3){
  #pragma unroll
  for(int d0=0;d0<2;++d0){s16x4 lo[4],hi[4];
    #pragma unroll
    for(int ks=0;ks<4;++ks){
      asm volatile("ds_read_b64_tr_b16 %0,%1 offset:%c2":"=&v"(lo[ks]):"v"(vb),"i"(d0*4096+ks*1024):"memory");
      asm volatile("ds_read_b64_tr_b16 %0,%1 offset:%c2":"=&v"(hi[ks]):"v"(vb),"i"(d0*4096+ks*1024+512):"memory");}
    asm volatile("s_waitcnt lgkmcnt(0)":::"memory");SBAR();
    #define PK(k) (bf16x8){lo[k][0],lo[k][1],lo[k][2],lo[k][3],hi[k][0],hi[k][1],hi[k][2],hi[k][3]}
    o[d0]=__builtin_amdgcn_mfma_f32_32x32x16_bf16(pa0,PK(0),o[d0],0,0,0);
    o[d0]=__builtin_amdgcn_mfma_f32_32x32x16_bf16(pa1,PK(1),o[d0],0,0,0);
    o[d0]=__builtin_amdgcn_mfma_f32_32x32x16_bf16(pa2,PK(2),o[d0],0,0,0);
    o[d0]=__builtin_amdgcn_mfma_f32_32x32x16_bf16(pa3,PK(3),o[d0],0,0,0);
    #undef PK
  }
}

#ifndef ATTN_STORE16
#define ATTN_STORE16(p,v) (*(u32x4*)(p)=(v))
#endif
typedef __attribute__((address_space(3))) const float* lds_fptr; typedef float f32x4a __attribute__((ext_vector_type(4)));
__device__ __forceinline__ void gload(f32x16&c0,f32x16&c1,lds_fptr g){
  #pragma unroll
  for(int q=0;q<4;++q){const f32x4a a=*(const __attribute__((address_space(3))) f32x4a*)(g+8*q),b=*(const __attribute__((address_space(3))) f32x4a*)(g+32+8*q);
    c0[4*q]=a[0];c0[4*q+1]=a[1];c0[4*q+2]=a[2];c0[4*q+3]=a[3];c1[4*q]=b[0];c1[4*q+1]=b[1];c1[4*q+2]=b[2];c1[4*q+3]=b[3];}
}
template<int THRL> __device__ __forceinline__ void attn_unit(int b,int h,int qb,const bf16*Q,const bf16*__restrict__ K,const bf16*__restrict__ V,bf16*O,char*shm,lds_fptr fk,int ts){
  const int tid=threadIdx.x,lane=tid&63,r32=lane&31,hi=lane>>5; const int wid=__builtin_amdgcn_readfirstlane(tid>>6);
  const long rowbase=(long)b*SEQ; const int q0=qb*QB;
  const bf16*Qw=Q+(rowbase+q0+wid*QBLK)*DM+h*D;
  const bf16*Kh=K+(rowbase+(long)ts*KVBLK)*DM+h*D,*Vh=V+(rowbase+(long)ts*KVBLK)*DM+h*D;
  const unsigned lds0=(unsigned)(uintptr_t)shm;
  float*wsf=(float*)(shm+LDS_WS)+wid*64;
  const bf16*ksrc=Kh+wid*8; const unsigned koff=(unsigned)lane*DM*2u;
  const bf16*vsrc=Vh+(long)(16*(wid&3))*DM+(wid>>2)*32; const unsigned voff=((unsigned)(lane>>2)*DM+(unsigned)(lane&3)*8u)*2u;
  const unsigned kdst=lds0+LDS_K+wid*1024, vdst=lds0+LDS_V+wid*1024;
  #define DMA_K(t,slot) glds16(ksrc+(long)(t)*KVBLK*DM,koff,(unsigned)__builtin_amdgcn_readfirstlane(kdst+(slot)))
  #define DMA_V(t,slot) glds16(vsrc+(long)(t)*KVBLK*DM,voff,(unsigned)__builtin_amdgcn_readfirstlane(vdst+(slot)))
  const char*Kbase=shm+LDS_K; bf16x8 kf[8];
  const lds_cptr shm3=(lds_cptr)shm; const lds_cptr kp0=shm3+LDS_K+hi*1024+r32*16; const lds_cptr vp0=shm3+LDS_V+((lane>>4)&1)*32+(lane&3)*8+(4*hi+((lane&15)>>2))*64;
  const int NT=(q0+QB)/KVBLK-ts;
  DMA_K(0,0);DMA_V(0,0);DMA_K(1,SLOTB);
  bf16x8 qr[4];
  #pragma unroll
  for(int d0=0;d0<4;++d0)qr[d0]=*reinterpret_cast<const bf16x8*>(&Qw[(long)r32*DM+d0*16+hi*8]);
  float mhat=0.f,l_reg=0.f;f32x16 o[2];o[0]=f32x16{};o[1]=f32x16{};
  #define GP0() ({ int hh_=hi; asm volatile("":"+v"(hh_)); fk+4*hh_; })
  const int qrel=wid*QBLK+r32;
  #define CMASK(P0,P1,t) do{int jb_=(t)-(NT-4); if(jb_>=0)cmask(P0,P1,jb_,qrel,hi);}while(0)
  bool resc=false;
  #define START(P0,P1) do{ const float rm=rowmax(P0,P1); resc=false; \
    { const float dl=rm; mhat=fadd_s(mhat,dl); \
      _Pragma("unroll") for(int r=0;r<16;++r){P0[r]=fsub_s(P0[r],dl);P1[r]=fsub_s(P1[r],dl);} } \
    _Pragma("unroll") for(int r=0;r<16;++r)P0[r]=__builtin_amdgcn_exp2f(P0[r]); }while(0)
  #define RESC() do{ if(resc){ asm volatile("s_waitcnt lgkmcnt(0)":::"memory"); \
      _Pragma("unroll") for(int d_=0;d_<2;++d_) _Pragma("unroll") for(int r=0;r<16;++r)o[d_][r]*=wsf[crow(r,hi)]; } }while(0)
  f32x16 pA0,pA1,pB0,pB1;
  int sl_prev=0,sl_cur=0,sl_next=SLOTB;
  #define ROT() do{sl_prev=sl_cur;sl_cur=sl_next;sl_next=(sl_next==(NSLOT-1)*SLOTB)?0:sl_next+SLOTB;}while(0)
  DMA_K(2,2*SLOTB);
  WAIT_BAR(3);
  gload(pA0,pA1,GP0()); qkt(pA0,pA1,Kbase,qr,r32,hi);asm volatile("s_nop 15\n\ts_nop 7":"+v"(pA0),"+v"(pA1));CMASK(pA0,pA1,0);
  START(pA0,pA1);
  _Pragma("unroll") for(int r=0;r<16;++r)pA1[r]=__builtin_amdgcn_exp2f(pA1[r]);
  WAIT_BAR(0);
  DMA_K(3,0);DMA_V(1,SLOTB);
  ROT();
  kload8(kf,kp0+sl_cur);
  gload(pB0,pB1,GP0()+64);
  WAIT_BAR(2);
  s16x4 vlo[8],vhi[8]; u32x4 pw0,pw1,pw2,pw3;
  #define PKW(P,B) cvtpk_s(P[B],P[B+1])
  #define PAF(k) __builtin_bit_cast(bf16x8,pw##k)
  #define VFR(i) (bf16x8){vlo[i][0],vlo[i][1],vlo[i][2],vlo[i][3],vhi[i][0],vhi[i][1],vhi[i][2],vhi[i][3]}
  #define PIN(x) asm volatile("":"+v"(x))
  #define MX3(a,b,c) __builtin_fmaxf(__builtin_fmaxf((a),(b)),(c))
  #define GAPA(MF,A0,A1,A2,A3,W0,W1,PW) do{ MF; sacc+=A0; sacc+=A1; sacc+=A2; sacc+=A3; PIN(sacc); W0; W1; PIN(PW); SBAR(); }while(0)
  #define EX(v) __builtin_amdgcn_exp2f(v)
  #define GAPB(MF,X,B) do{ MF; X[B]=EX(X[B]); X[B+1]=EX(X[B+1]); X[B+2]=EX(X[B+2]); X[B+3]=EX(X[B+3]); PIN(X); SBAR(); }while(0)
  #define VRD(i) do{ vlo[i]=vtr(vp_+(((i)>>2)*4096+((i)&3)*1024)); vhi[i]=vtr(vp_+(((i)>>2)*4096+((i)&3)*1024+512)); }while(0)
  #define KRD(G,j) do{ if(G){ kload2(kf,kp0+sl_next,j); SBAR(); } }while(0)
  #define STEP(C0,C1,P0,P1,t,GK,GV,GL) do{ SBAR(); \
    const lds_cptr vp_=vp0+sl_prev; \
    VRD(0); SBAR(); float sacc=(P0[0]+P0[1]); \
    GAPA(C0=__builtin_amdgcn_mfma_f32_32x32x16_bf16(kf[0],qr[0],C0,0,0,0), P0[2],P0[3],P0[4],P0[5],     pw0[0]=PKW(P0,0), pw0[1]=PKW(P0,2), pw0); \
    VRD(4); SBAR(); GAPA(C1=__builtin_amdgcn_mfma_f32_32x32x16_bf16(kf[1],qr[0],C1,0,0,0), P0[6],P0[7],P0[8],P0[9],     pw0[2]=PKW(P0,4), pw0[3]=PKW(P0,6), pw0); \
    VRD(1); SBAR(); GAPA(C0=__builtin_amdgcn_mfma_f32_32x32x16_bf16(kf[2],qr[1],C0,0,0,0),   P0[10],P0[11],P0[12],P0[13], pw1[0]=PKW(P0,8), pw1[1]=PKW(P0,10), pw1); \
    VRD(5); SBAR(); GAPA(C1=__builtin_amdgcn_mfma_f32_32x32x16_bf16(kf[3],qr[1],C1,0,0,0),   P0[14],P0[15],P1[0],P1[1],   pw1[2]=PKW(P0,12),pw1[3]=PKW(P0,14), pw1); \
    VRD(2); SBAR(); GAPA(C0=__builtin_amdgcn_mfma_f32_32x32x16_bf16(kf[4],qr[2],C0,0,0,0),   P1[2],P1[3],P1[4],P1[5],     pw2[0]=PKW(P1,0), pw2[1]=PKW(P1,2), pw2); \
    VRD(6); SBAR(); GAPA(C1=__builtin_amdgcn_mfma_f32_32x32x16_bf16(kf[5],qr[2],C1,0,0,0),   P1[6],P1[7],P1[8],P1[9],     pw2[2]=PKW(P1,4), pw2[3]=PKW(P1,6), pw2); \
    VRD(3); SBAR(); GAPA(C0=__builtin_amdgcn_mfma_f32_32x32x16_bf16(kf[6],qr[3],C0,0,0,0),   P1[10],P1[11],P1[12],P1[13], pw3[0]=PKW(P1,8), pw3[1]=PKW(P1,10), pw3); \
    VRD(7); SBAR(); GAPA(C1=__builtin_amdgcn_mfma_f32_32x32x16_bf16(kf[7],qr[3],C1,0,0,0),   P1[14],P1[15],0.f,0.f,       pw3[2]=PKW(P1,12),pw3[3]=PKW(P1,14), pw3); \
    l_reg+=sacc; \
    if(GK){DMA_K((t)+3,sl_cur);} if(GV){DMA_V((t)+1,sl_next);} \
    CMASK(C0,C1,t); \
    { float a=MX3(C0[0],C0[1],C1[0]),b=MX3(C0[2],C0[3],C1[1]); a=MX3(a,C1[2],C1[3]); \
      _Pragma("unroll") for(int r=4;r<16;r+=4){a=MX3(a,C0[r],C0[r+1]);b=MX3(b,C0[r+2],C0[r+3]);a=MX3(a,C1[r],C1[r+1]);b=MX3(b,C1[r+2],C1[r+3]);} \
      float rm=__builtin_fmaxf(a,b); { auto rr=__builtin_amdgcn_permlane32_swap(__float_as_uint(rm),__float_as_uint(rm),false,false); rm=__builtin_fmaxf(__uint_as_float(rr[0]),__uint_as_float(rr[1])); } \
      resc=false; const float dlt=rm-mhat; \
      if(__any(dlt>(float)THRL)){ const float dl=__builtin_fmaxf(dlt,0.f); mhat+=dl; \
        const float f=__builtin_amdgcn_exp2f(-dl); l_reg*=f; if(hi==0)wsf[r32]=f; resc=true; } \
      _Pragma("unroll") for(int r=0;r<16;++r){C0[r]-=mhat;C1[r]-=mhat;} } \
    SBAR(); \
    GAPB(o[0]=__builtin_amdgcn_mfma_f32_32x32x16_bf16(PAF(0),VFR(0),o[0],0,0,0), C0,0); \
    GAPB(o[1]=__builtin_amdgcn_mfma_f32_32x32x16_bf16(PAF(0),VFR(4),o[1],0,0,0), C0,4); \
    KRD(GL,0); GAPB(o[0]=__builtin_amdgcn_mfma_f32_32x32x16_bf16(PAF(1),VFR(1),o[0],0,0,0), C0,8); \
    KRD(GL,1); GAPB(o[1]=__builtin_amdgcn_mfma_f32_32x32x16_bf16(PAF(1),VFR(5),o[1],0,0,0), C0,12); \
    KRD(GL,2); GAPB(o[0]=__builtin_amdgcn_mfma_f32_32x32x16_bf16(PAF(2),VFR(2),o[0],0,0,0), C1,0); \
    KRD(GL,3); GAPB(o[1]=__builtin_amdgcn_mfma_f32_32x32x16_bf16(PAF(2),VFR(6),o[1],0,0,0), C1,4); \
    GAPB(o[0]=__builtin_amdgcn_mfma_f32_32x32x16_bf16(PAF(3),VFR(3),o[0],0,0,0), C1,8); \
    GAPB(o[1]=__builtin_amdgcn_mfma_f32_32x32x16_bf16(PAF(3),VFR(7),o[1],0,0,0), C1,12); \
    if(GL){ gload(P0,P1,GP0()+((t)+1)*64); } \
    }while(0)
  int t=1;
  #undef CMASK
  #define CMASK(P0,P1,t) do{}while(0)
  for(;t+5<NT;t+=2){
    STEP(pB0,pB1,pA0,pA1,t,true,true,true);     WAIT_BAR(2); RESC(); ROT();
    STEP(pA0,pA1,pB0,pB1,t+1,true,true,true);   WAIT_BAR(2); RESC(); ROT();
  }
  #undef CMASK
  #define CMASK(P0,P1,t) do{int jb_=(t)-(NT-4); if(jb_>=0)cmask(P0,P1,jb_,qrel,hi);}while(0)
  #define ENDW(tt) do{ if((tt)+3<NT){WAIT_BAR(2);} else if((tt)+2<NT){WAIT_BAR(1);} else {WAIT_BAR(0);} }while(0)
  for(;t+1<NT;t+=2){
    STEP(pB0,pB1,pA0,pA1,t,(t+3<NT),(t+1<NT),(t+1<NT));       ENDW(t);   RESC(); ROT();
    STEP(pA0,pA1,pB0,pB1,t+1,(t+4<NT),(t+2<NT),(t+2<NT));     ENDW(t+1); RESC(); ROT();
  }
  STEP(pB0,pB1,pA0,pA1,NT-1,false,false,false); RESC();
  { float sacc=pB0[0]+pB0[1]; _Pragma("unroll") for(int r=2;r<16;++r)sacc+=pB0[r]; _Pragma("unroll") for(int r=0;r<16;++r)sacc+=pB1[r]; l_reg+=sacc;
    pw0=(u32x4){PKW(pB0,0),PKW(pB0,2),PKW(pB0,4),PKW(pB0,6)};pw1=(u32x4){PKW(pB0,8),PKW(pB0,10),PKW(pB0,12),PKW(pB0,14)};pw2=(u32x4){PKW(pB1,0),PKW(pB1,2),PKW(pB1,4),PKW(pB1,6)};pw3=(u32x4){PKW(pB1,8),PKW(pB1,10),PKW(pB1,12),PKW(pB1,14)};
    SBAR(); pv(o,(int)(unsigned)(__UINTPTR_TYPE__)(vp0+sl_cur),PAF(0),PAF(1),PAF(2),PAF(3)); }
  #undef PKW
  #undef PAF
  #undef VFR
  #undef PIN
  #undef MX3
  #undef GAPA
  #undef GAPB
  #undef EX
  #undef VRD
  #undef KRD
  #undef STEP
  #undef ENDW
  {auto rr=__builtin_amdgcn_permlane32_swap(__float_as_uint(l_reg),__float_as_uint(l_reg),false,false);l_reg=__uint_as_float(rr[0])+__uint_as_float(rr[1]);}
  if(hi==0)wsf[32+r32]=l_reg;asm volatile("s_waitcnt lgkmcnt(0)":::"memory");
  float rli[16];
  #pragma unroll
  for(int r=0;r<16;++r)rli[r]=__builtin_amdgcn_rcpf(wsf[32+crow(r,hi)]);
  bf16*Ow=O+(rowbase+q0+wid*QBLK)*OPITCH+h*D;
  { bf16*stg=(bf16*)(shm+LDS_OST)+wid*2048;
    #pragma unroll
    for(int r=0;r<16;++r){const int orow=crow(r,hi);
      #pragma unroll
      for(int d0=0;d0<2;++d0)stg[orow*64+d0*32+r32]=__float2bfloat16(o[d0][r]*rli[r]);}
    asm volatile("s_waitcnt lgkmcnt(0)":::"memory");
    #pragma unroll
    for(int i=0;i<4;++i){const int row=i*8+(lane>>3),ch=lane&7; const u32x4 v=*(const u32x4*)(stg+row*64+ch*8); ATTN_STORE16(Ow+(long)row*OPITCH+ch*8,v);} }
  asm volatile("s_waitcnt lgkmcnt(0)\n\ts_barrier":::"memory");
  #undef DMA_K
  #undef DMA_V
  #undef CMASK
  #undef START
  #undef RESC
  #undef ROT
}
constexpr int ATTN_LDS_BYTES=LDS_BYTES;
struct AttnTensors { const bf16* Q; const bf16* K; const bf16* V; bf16* O; };
struct AttnUnit { int bh; int qb; };
struct StaticOrder {
  int vcu;
  __device__ __forceinline__ explicit StaticOrder(int grid,int block):vcu((block%8)*(grid/8)+block/8){}
  __device__ __forceinline__ bool next(int i,AttnUnit&u)const{ if(i>=4)return false; const int s=vcu&7; u.bh=vcu>>3; u.qb=(i==0)?s:(i==1)?15-s:(i==2)?16+s:31-s; return true; }
  __device__ __forceinline__ void a_ready(const AttnUnit&)const{}
  __device__ __forceinline__ void done(const AttnUnit&)const{}
};
#undef SBAR
#undef WAIT_BAR
}
namespace cg = cooperative_groups;
#ifndef MK_COOP
#define MK_COOP 1
#endif
constexpr int NWAVES = 8;
constexpr int BATCH = 2, T = 8192, D = 1024, M = BATCH * T, NH = 8, HD = 64, CW = 512, DFF = 2816, NUP = 2 * DFF, NIN = 5120, INW = 5128, NMOD = 6 * D;
constexpr float RMS_EPS = 1e-6f, LOG2E = 1.4426950408889634f;
constexpr int N_PHASES = 12;
constexpr size_t MiB = 1u << 20;
constexpr size_t WS_CTL = 0, CTL_ZERO_BYTES = 81920;
constexpr size_t WS_MODACC = 4096, WS_SSQ = 131072, WS_CVEC = 262144;
constexpr size_t WS_UNITCTR = 512, WS_UINFO = 524288;
constexpr size_t WS_LF = 1 * MiB, WS_G = WS_LF + 512 * 1024;
constexpr size_t WS_WIN = 2 * MiB, WS_WAB = 12 * MiB, WS_WOUT = 14 * MiB, WS_WUP = 16 * MiB, WS_WDN = 27 * MiB;
constexpr size_t WS_XN = 34 * MiB, WS_YAB = WS_XN;
constexpr size_t WS_CB = 66 * MiB, WS_CC = 82 * MiB, WS_CV = 98 * MiB, WS_Q = 114 * MiB, WS_K = 130 * MiB, WS_V = 146 * MiB, WS_GA = 162 * MiB, WS_GB = 194 * MiB;
constexpr size_t WS_MERGED = 66 * MiB;
constexpr size_t WS_UH = 66 * MiB, WS_ACT = 154 * MiB, WS_END = 242 * MiB;
static_assert(WS_WDN + (size_t)D * DFF * 2 <= WS_XN && WS_UH + (size_t)T * NUP * 2 <= WS_ACT && WS_ACT + (size_t)M * DFF * 2 <= WS_END, "ws map");

#define LAS __attribute__((address_space(3)))
typedef unsigned short bfu;
typedef unsigned v4u __attribute__((ext_vector_type(4)));
typedef float f32x4 __attribute__((ext_vector_type(4)));
#define LDS_WAIT() asm volatile("s_waitcnt lgkmcnt(0)" ::: "memory")
__device__ __forceinline__ unsigned f2bf(float f) { unsigned u = __builtin_bit_cast(unsigned, f); return (u + 0x7fffu + ((u >> 16) & 1u)) >> 16; }
__device__ __forceinline__ unsigned pk2(float lo, float hi) { unsigned r; asm("v_cvt_pk_bf16_f32 %0, %1, %2" : "=v"(r) : "v"(lo), "v"(hi)); return r; }
__device__ __forceinline__ float blo(unsigned w) { return __uint_as_float(w << 16); }
__device__ __forceinline__ float bhi(unsigned w) { return __uint_as_float(w & 0xffff0000u); }
__device__ __forceinline__ float wave_sum(float v) {
#pragma unroll
    for (int o = 1; o < 64; o <<= 1) v += __shfl_xor(v, o);
    return v;
}
__device__ __forceinline__ float siluf_(float x) { return x * __builtin_amdgcn_rcpf(1.0f + __expf(-x)); }

#define XB_TMO      128
#define XB_XCNT(j)  (256  + 64 * (j))
#define XB_XSUB(j)  (1280 + 64 * (j))
#define XB_XGEN(j)  (2304 + 64 * (j))
#define XB_TOP      3328
#define XB_TOPGEN   3392
#define XCD_BAR_WORDS 3456
#define XB_SPIN_CAP (1u << 18)

__device__ __forceinline__ unsigned xb_ld(unsigned* p)              { return __hip_atomic_load(p, __ATOMIC_RELAXED, __HIP_MEMORY_SCOPE_AGENT); }
__device__ __forceinline__ unsigned xb_add(unsigned* p, unsigned v) { return __hip_atomic_fetch_add(p, v, __ATOMIC_RELAXED, __HIP_MEMORY_SCOPE_AGENT); }
__device__ __forceinline__ unsigned xb_xcc_id() { return (unsigned)__builtin_amdgcn_s_getreg((3 << 11) | 20) & 0xFu; }
#define XB_SPIN(cond, bar) do { unsigned _sp = 0; while (cond) { __builtin_amdgcn_s_sleep(1); \
    if ((++_sp & 255u) == 0u) { if (xb_ld(&(bar)[XB_TMO])) break; if (_sp > XB_SPIN_CAP) { atomicAdd(&(bar)[XB_TMO], 1u); break; } } } } while (0)

struct XcdBarrier {
    unsigned* bar; unsigned x;
    volatile LAS unsigned* st;
};

__device__ __forceinline__ XcdBarrier xcd_barrier_post(unsigned* bar, volatile LAS unsigned* st) {
    XcdBarrier b; b.bar = bar; b.x = xb_xcc_id(); b.st = st;
    if (threadIdx.x == 0) (void)xb_add(&bar[XB_XCNT(b.x)], 1u);
    return b;
}
__device__ __forceinline__ void xcd_barrier_complete(unsigned* bar, unsigned x, unsigned& nloc, unsigned& nx) {
    const unsigned G = gridDim.x * gridDim.y * gridDim.z;
    unsigned sum, cnt, mine, sp = 0u;
    for (;;) {
        sum = 0u; cnt = 0u; mine = 0u;
#pragma unroll
        for (unsigned j = 0; j < 16; ++j) { const unsigned c = xb_ld(&bar[XB_XCNT(j)]); sum += c; cnt += (c > 0u) ? 1u : 0u; mine = (j == x) ? c : mine; }
        if (sum == G) break;
        __builtin_amdgcn_s_sleep(1);
        if ((++sp & 255u) == 0u) { if (xb_ld(&bar[XB_TMO])) break; if (sp > XB_SPIN_CAP) { atomicAdd(&bar[XB_TMO], 1u); break; } }
    }
    nloc = mine > 0u ? mine : 1u; nx = cnt > 0u ? cnt : 1u;
}

__device__ __forceinline__ void xcd_barrier(const XcdBarrier& b) {
    asm volatile("s_waitcnt vmcnt(0)" ::: "memory");
    __syncthreads();
    if (threadIdx.x == 0) {
        unsigned* bar = b.bar;
        __builtin_amdgcn_s_waitcnt(0);
        unsigned nloc = b.st[0], nx = b.st[1];
        if (nloc == 0u) { xcd_barrier_complete(bar, b.x, nloc, nx); b.st[0] = nloc; b.st[1] = nx; }
        const unsigned old = xb_add(&bar[XB_XSUB(b.x)], 1u);
        const unsigned gen = old / nloc;
        if (old + 1u == (gen + 1u) * nloc) {
            __builtin_amdgcn_fence(__ATOMIC_RELEASE, "agent");
            asm volatile("s_waitcnt vmcnt(0)" ::: "memory");
            const unsigned og = xb_add(&bar[XB_TOP], 1u);
            const unsigned tg = og / nx;
            if (og + 1u == (tg + 1u) * nx) xb_add(&bar[XB_TOPGEN], 1u);
            else XB_SPIN(xb_ld(&bar[XB_TOPGEN]) == tg, bar);
            __builtin_amdgcn_fence(__ATOMIC_ACQUIRE, "agent");
            xb_add(&bar[XB_XGEN(b.x)], 1u);
            asm volatile("s_waitcnt vmcnt(0)" ::: "memory");
        } else {
            XB_SPIN(xb_ld(&bar[XB_XGEN(b.x)]) == gen, bar);
            __builtin_amdgcn_fence(__ATOMIC_ACQUIRE, "agent");
            asm volatile("s_waitcnt vmcnt(0)" ::: "memory");
        }
    }
    __syncthreads();
}
__device__ __forceinline__ void grid_bar(unsigned* ctr, unsigned target) {
    asm volatile("s_waitcnt vmcnt(0) lgkmcnt(0)" ::: "memory");
    __syncthreads();
    if (threadIdx.x == 0) {
        __builtin_amdgcn_fence(__ATOMIC_RELEASE, "agent");
        asm volatile("s_waitcnt vmcnt(0)" ::: "memory");
        __hip_atomic_fetch_add(ctr, 1u, __ATOMIC_RELAXED, __HIP_MEMORY_SCOPE_AGENT);
        while (__hip_atomic_load(ctr, __ATOMIC_RELAXED, __HIP_MEMORY_SCOPE_AGENT) < target) __builtin_amdgcn_s_sleep(2);
        __builtin_amdgcn_fence(__ATOMIC_ACQUIRE, "agent");
        asm volatile("s_waitcnt vmcnt(0)" ::: "memory");
    }
    __syncthreads();
}
struct Args { const float* in[17]; float* out; unsigned char* ws; int ph_lo, ph_hi; };
enum { I_X = 0, I_C, I_WADA, I_BADA, I_N1G, I_WIN, I_BF, I_CONVA, I_QG, I_KG, I_WBA, I_WBB, I_WOUT, I_N2G, I_WUP, I_CONVF, I_WDN };

__device__ __forceinline__ void transpose_item(const float* W, int ldw, int k0, int c0, bfu* WT, int K, int dk0, int drow0, LAS float* scr, int lane) {
    { const int kr = lane >> 3, nc = (lane & 7) * 4; f32x4 v[8];
#pragma unroll
      for (int i = 0; i < 8; ++i) v[i] = __builtin_nontemporal_load((const f32x4*)(W + (size_t)(k0 + 8 * i + kr) * ldw + c0 + nc));
#pragma unroll
      for (int i = 0; i < 8; ++i) { LAS float* d = scr + (8 * i + kr) * 33 + nc; d[0] = v[i].x; d[1] = v[i].y; d[2] = v[i].z; d[3] = v[i].w; } }
    LDS_WAIT(); asm volatile("" ::: "memory");
    const int c = lane & 7;
#pragma unroll
    for (int j = 0; j < 4; ++j) { const int n = (lane >> 3) + 8 * j; const LAS float* s = scr + (8 * c) * 33 + n;
        v4u o; o.x = pk2(s[0 * 33], s[1 * 33]); o.y = pk2(s[2 * 33], s[3 * 33]); o.z = pk2(s[4 * 33], s[5 * 33]); o.w = pk2(s[6 * 33], s[7 * 33]);
        *(v4u*)(WT + (size_t)(drow0 + n) * K + dk0 + 8 * c) = o; }
    LDS_WAIT(); asm volatile("" ::: "memory");
}

template <int NK = 64> __device__ __forceinline__ void gemv2_item(const float* W, int ldw, int n0, int k0, float c0, float c1, float* out0, float* out1, int lane) {
    f32x4 s0 = {0.f, 0.f, 0.f, 0.f}, s1 = {0.f, 0.f, 0.f, 0.f};
    const float* wp = W + (size_t)k0 * ldw + n0 + 4 * lane;
#pragma unroll 16
    for (int kk = 0; kk < NK; ++kk) { const f32x4 w = __builtin_nontemporal_load((const f32x4*)(wp + (size_t)kk * ldw)); s0 += w * __shfl(c0, kk); s1 += w * __shfl(c1, kk); }
    float* o0 = out0 + n0 + 4 * lane; float* o1 = out1 + n0 + 4 * lane;
    atomicAdd(o0, s0.x); atomicAdd(o0 + 1, s0.y); atomicAdd(o0 + 2, s0.z); atomicAdd(o0 + 3, s0.w);
    atomicAdd(o1, s1.x); atomicAdd(o1 + 1, s1.y); atomicAdd(o1 + 2, s1.z); atomicAdd(o1 + 3, s1.w);
}
template <bool FLOG>
__device__ __forceinline__ void norm_rows(const float* X, const float* gain, const float* modacc, const float* bada, int sh_slot, int sc_slot, bfu* XN, const LAS float* wf, const float* bf_, float* LF, int gw, int NGW, int lane) {
    for (int m0 = gw * 8; m0 < M; m0 += NGW * 8) {
        const int b = m0 / T;
        f32x4 A[4], Bv[4];
#pragma unroll
        for (int j = 0; j < 4; ++j) { const int col = 256 * j + 4 * lane;
            const f32x4 g = *(const f32x4*)(gain + col);
            const f32x4 sc = *(const f32x4*)(modacc + b * NMOD + sc_slot * D + col) + *(const f32x4*)(bada + sc_slot * D + col);
            const f32x4 sh = *(const f32x4*)(modacc + b * NMOD + sh_slot * D + col) + *(const f32x4*)(bada + sh_slot * D + col);
            A[j] = g * (sc + 1.0f); Bv[j] = sh; }
        f32x4 vv[2][4][4];
#pragma unroll
        for (int g = 0; g < 2; ++g)
#pragma unroll
            for (int q = 0; q < 4; ++q) { const f32x4* xr = (const f32x4*)(X + (size_t)(m0 + 4 * g + q) * D) + lane;
#pragma unroll
                for (int j = 0; j < 4; ++j) vv[g][q][j] = __builtin_nontemporal_load(xr + 64 * j); }
#pragma unroll
        for (int g = 0; g < 2; ++g) { const int r0 = 4 * g;
            f32x4 (&v)[4][4] = vv[g]; float s2[4];
#pragma unroll
            for (int q = 0; q < 4; ++q) { s2[q] = 0.f;
#pragma unroll
                for (int j = 0; j < 4; ++j) s2[q] += (v[q][j].x * v[q][j].x + v[q][j].y * v[q][j].y) + (v[q][j].z * v[q][j].z + v[q][j].w * v[q][j].w); }
#pragma unroll
            for (int o = 1; o < 64; o <<= 1) {
#pragma unroll
                for (int q = 0; q < 4; ++q) s2[q] += __shfl_xor(s2[q], o); }
#pragma unroll
            for (int q = 0; q < 4; ++q) { const int m = m0 + r0 + q;
                const float inv = __builtin_amdgcn_rsqf(s2[q] * (1.0f / D) + RMS_EPS);
                unsigned long long* o8 = (unsigned long long*)(XN + (size_t)m * D) + lane;
#pragma unroll
                for (int j = 0; j < 4; ++j) { v[q][j] = v[q][j] * inv * A[j] + Bv[j];
                    o8[64 * j] = (unsigned long long)pk2(v[q][j].x, v[q][j].y) | ((unsigned long long)pk2(v[q][j].z, v[q][j].w) << 32); }
                if (FLOG) {
                    asm volatile("" ::: "memory");
                    float p[8];
#pragma unroll
                    for (int h = 0; h < 8; ++h) { p[h] = 0.f;
#pragma unroll
                        for (int j = 0; j < 4; ++j) { const f32x4 w = *(const LAS f32x4*)(wf + h * D + 256 * j + 4 * lane); p[h] += (v[q][j].x * w.x + v[q][j].y * w.y) + (v[q][j].z * w.z + v[q][j].w * w.w); } }
#pragma unroll
                    for (int h = 0; h < 4; ++h) { const float send = (lane & 1) ? p[h] : p[h + 4], keep = (lane & 1) ? p[h + 4] : p[h]; p[h] = keep + __shfl_xor(send, 1); }
#pragma unroll
                    for (int h = 0; h < 2; ++h) { const float send = (lane & 2) ? p[h] : p[h + 2], keep = (lane & 2) ? p[h + 2] : p[h]; p[h] = keep + __shfl_xor(send, 2); }
                    { const float send = (lane & 4) ? p[0] : p[1], keep = (lane & 4) ? p[1] : p[0]; p[0] = keep + __shfl_xor(send, 4); }
                    p[0] += __shfl_xor(p[0], 8); p[0] += __shfl_xor(p[0], 16); p[0] += __shfl_xor(p[0], 32);
                    if (lane < 8) { const int h = ((lane & 1) << 2) | (lane & 2) | ((lane & 4) >> 2); const float z = p[0] + bf_[h]; LF[(size_t)((m / T) * 8 + h) * T + (m % T)] = fminf(z, 0.f) - log1pf(__expf(-fabsf(z))); }
                }
            }
        }
    }
}

__global__ void __launch_bounds__(NWAVES * 64, 2) fwd_kernel(Args args) {
    extern __shared__ __attribute__((aligned(16))) unsigned char lds[];
    LAS unsigned char* ldsp = (LAS unsigned char*)lds;
    const int wave = __builtin_amdgcn_readfirstlane((int)threadIdx.x >> 6);
    const int G = gridDim.x; const int bx = blockIdx.x; const int vcu = (G % 8 == 0) ? (bx % 8) * (G / 8) + bx / 8 : bx;
    const int gw = vcu * NWAVES + wave, NGW = G * NWAVES;
#define PH_IDS int tid = threadIdx.x; asm volatile("" : "+v"(tid)); const int lane = tid & 63; (void)lane
    unsigned char* ws = args.ws;
    float* modacc = (float*)(ws + WS_MODACC);
    float* ssq = (float*)(ws + WS_SSQ); float* cvec = (float*)(ws + WS_CVEC);
    float* LF = (float*)(ws + WS_LF); float* GF = (float*)(ws + WS_G);
    bfu *Win_t = (bfu*)(ws + WS_WIN), *Wab_t = (bfu*)(ws + WS_WAB), *Wout_t = (bfu*)(ws + WS_WOUT), *Wup_t = (bfu*)(ws + WS_WUP), *Wdn_t = (bfu*)(ws + WS_WDN);
    bfu *XN = (bfu*)(ws + WS_XN), *YAB = (bfu*)(ws + WS_YAB), *CB = (bfu*)(ws + WS_CB), *CC = (bfu*)(ws + WS_CC), *CV = (bfu*)(ws + WS_CV);
    bfu *QB = (bfu*)(ws + WS_Q), *KB = (bfu*)(ws + WS_K), *VB = (bfu*)(ws + WS_V), *GA = (bfu*)(ws + WS_GA), *GB = (bfu*)(ws + WS_GB);
    bfu* X1B = (bfu*)(ws + 100 * MiB);
    bfu *MERGED = (bfu*)(ws + WS_MERGED), *UH = (bfu*)(ws + WS_UH), *ACT = (bfu*)(ws + WS_ACT);
    const float* x = args.in[I_X]; float* out = args.out; const float* bada = args.in[I_BADA];
    const int lo = args.ph_lo, hi = args.ph_hi;
#ifndef PHMASK
#define PHMASK 0xfff
#endif
#define IN(k) (((PHMASK >> (k)) & 1) && lo <= (k) && (k) < hi)
    { volatile LAS unsigned* misc = (volatile LAS unsigned*)(ldsp + 146432); if (threadIdx.x < 2) misc[threadIdx.x] = 0u; __syncthreads(); }
    if (args.ph_lo < 0) cg::this_grid().sync();
    const XcdBarrier xbar = xcd_barrier_post((unsigned*)(ws + WS_CTL + 65536), (volatile LAS unsigned*)(ldsp + 146432));
    unsigned* barctr = (unsigned*)(ws + WS_CTL + 256);
#define SEAM(k) do { if (IN(k) && (IN((k) + 1) || ((k) == 5 && IN(7)) || ((k) == 7 && IN(11)))) { xcd_barrier(xbar); } } while (0)

    if (IN(0)) {
        PH_IDS;
        for (int i = (vcu * NWAVES * 64) + tid; i < M; i += G * NWAVES * 64) ssq[i] = 0.f;
        { LAS float* red = (LAS float*)ldsp;
          for (int it = vcu; it < 24 * 8; it += G) {
            const int nb = it % 24, kc = it / 24, k0 = kc * 128 + wave * 16; const float* c = args.in[I_C];
            const float c0 = siluf_(c[k0 + (lane & 15)]), c1 = siluf_(c[D + k0 + (lane & 15)]);
            f32x4 s0 = {0.f, 0.f, 0.f, 0.f}, s1 = {0.f, 0.f, 0.f, 0.f};
            const float* wp = args.in[I_WADA] + (size_t)k0 * NMOD + nb * 256 + 4 * lane;
#pragma unroll
            for (int kk = 0; kk < 16; ++kk) { const f32x4 w = __builtin_nontemporal_load((const f32x4*)(wp + (size_t)kk * NMOD)); s0 += w * __shfl(c0, kk); s1 += w * __shfl(c1, kk); }
            *(LAS f32x4*)(red + (wave * 2 + 0) * 256 + 4 * lane) = s0; *(LAS f32x4*)(red + (wave * 2 + 1) * 256 + 4 * lane) = s1;
            __syncthreads();
            { const int bsel = tid >> 8, col = tid & 255; float a = 0.f;
#pragma unroll
              for (int w = 0; w < 8; ++w) a += red[(w * 2 + bsel) * 256 + col];
              atomicAdd(modacc + bsel * NMOD + nb * 256 + col, a); }
            __syncthreads();
          } }
    }
    SEAM(0);
    if (IN(1)) {
        PH_IDS;
        LAS float* wf = (LAS float*)ldsp;
        for (int k = tid; k < D; k += NWAVES * 64) { const float* src = args.in[I_WIN] + (size_t)k * INW + 3072; const f32x4 a = *(const f32x4*)src, b = *(const f32x4*)(src + 4);
            wf[0 * D + k] = a.x; wf[1 * D + k] = a.y; wf[2 * D + k] = a.z; wf[3 * D + k] = a.w; wf[4 * D + k] = b.x; wf[5 * D + k] = b.y; wf[6 * D + k] = b.z; wf[7 * D + k] = b.w; }
        __syncthreads();
        norm_rows<true>(x, args.in[I_N1G], modacc, bada, 0, 1, XN, wf, args.in[I_BF], LF, gw, NGW, lane);
        {
            LAS float* scr = (LAS float*)(ldsp + 32768 + wave * 8448);
            constexpr int I_IN = 16 * 160, I_AB = 16 * 32, I_OUT = 16 * 32, I_UP = 16 * 176, I_DN = 44 * 32;
            constexpr int NITEMS = I_IN + I_AB + I_OUT + I_UP + I_DN;
            for (int it = gw; it < NITEMS; it += NGW) {
                int r = it;
                if (r < I_IN) { const int kb = r / 160, db = r % 160, d0 = 32 * db, pn = d0 >> 8, s = d0 & 255;
                    int srcs = s; if (pn >= 6 && pn < 10) { const int bj = s >> 7, wc = (s >> 5) & 3; srcs = 64 * wc + 32 * bj; }
                    int col = 256 * pn + srcs; if (col >= 3072) col += 8;
                    transpose_item(args.in[I_WIN], INW, 64 * kb, col, Win_t, D, 64 * kb, d0, scr, lane); continue; }
                r -= I_IN;
                if (r < I_AB) { const int kb = r / 32, nb = r % 32;
                    transpose_item(kb < 8 ? args.in[I_WBA] : args.in[I_WBB], D, 64 * (kb & 7), 32 * nb, Wab_t, D, 64 * kb, 32 * nb, scr, lane); continue; }
                r -= I_AB;
                if (r < I_OUT) { const int kb = r / 32, nb = r % 32; transpose_item(args.in[I_WOUT], D, 64 * kb, 32 * nb, Wout_t, D, 64 * kb, 32 * nb, scr, lane); continue; }
                r -= I_OUT;
                if (r < I_UP) { const int kb = r / 176, nb = r % 176, d0 = 32 * nb; const int col = ((d0 & 255) >> 7) * DFF + 128 * (d0 >> 8) + (d0 & 127);
                    transpose_item(args.in[I_WUP], NUP, 64 * kb, col, Wup_t, D, 64 * kb, d0, scr, lane); continue; }
                r -= I_UP;
                { const int kb = r / 32, nb = r % 32; transpose_item(args.in[I_WDN], D, 64 * kb, 32 * nb, Wdn_t, DFF, 64 * kb, 32 * nb, scr, lane); }
            }
        }
        __syncthreads();
    }
    SEAM(1);
    if (IN(2)) {
        PH_IDS;
        if (bx < 16) {
            LAS float* tot = (LAS float*)(ldsp + 140 * 1024);
            const int t0 = wave * 1024 + lane * 16;
            float v[16];
            { const f32x4* lf4 = (const f32x4*)(LF + (size_t)bx * T + t0);
#pragma unroll
              for (int j = 0; j < 4; ++j) { const f32x4 q = lf4[j]; v[4 * j] = q.x; v[4 * j + 1] = q.y; v[4 * j + 2] = q.z; v[4 * j + 3] = q.w; } }
#pragma unroll
            for (int j = 1; j < 16; ++j) v[j] += v[j - 1];
            float incl = v[15];
#pragma unroll
            for (int o = 1; o < 64; o <<= 1) { const float y = __shfl_up(incl, o); if (lane >= o) incl += y; }
            const float excl = incl - v[15];
            if (lane == 63) tot[wave] = incl;
            __syncthreads();
            float off = 0.f;
            for (int w = 0; w < wave; ++w) off += tot[w];
#pragma unroll
            for (int j = 0; j < 16; ++j) GF[(size_t)bx * T + t0 + j] = -(off + excl + v[j]) * LOG2E;
            LAS float* Gl = (LAS float*)ldsp;
#pragma unroll
            for (int j = 0; j < 16; ++j) Gl[t0 + j] = -(off + excl + v[j]) * LOG2E;
            float cthr;
            { const float gq = fabsf(args.in[I_QG][lane]), gk = fabsf(args.in[I_KG][lane]); float mq = gq, mk = gk;
#pragma unroll
              for (int o = 1; o < 64; o <<= 1) { mq = fmaxf(mq, __shfl_xor(mq, o)); mk = fmaxf(mk, __shfl_xor(mk, o)); }
              cthr = 2.0f * (8.0f * mq * mk * 1.02f * LOG2E) + 32.0f; }
            __syncthreads();
            if (tid < 32) { const int qb = tid, NT = 4 * (qb + 1); const float gq0 = Gl[256 * qb]; int lo_ = 0, hi_ = NT / 2 - 2;
                while (lo_ < hi_) { const int mid = (lo_ + hi_ + 1) >> 1; if (gq0 - Gl[128 * mid - 1] > cthr) lo_ = mid; else hi_ = mid - 1; }
                ((int*)(ws + WS_UINFO))[bx * 32 + qb] = 2 * lo_; }
            __syncthreads();
        }
        pg8::Gemm g{XN, Win_t, M, NIN, D}; pg8::StaticOrder S; S.init(M, NIN, G, bx);
        pg8::EpiIn E{CB, (size_t)(16 * MiB / 2), (size_t)((WS_GA - WS_CB) / 2), (size_t)(32 * MiB / 2), args.in[I_QG], (long)(args.in[I_KG] - args.in[I_QG]), 0.125f * LOG2E, RMS_EPS};
        pg8::gemm_phase<pg8::EpiIn, pg8::StaticOrder, true, true>(ldsp, g, S, E);
    }
    SEAM(2);
    if (IN(3)) {
        PH_IDS;
        LAS float* fk = (LAS float*)(ldsp + 86016);
        LAS int* ucost = (LAS int*)(ldsp + 122880); LAS int* uord = ucost + 512; LAS int* slot = uord + 512;
        { const int u = tid; ucost[u] = 4 * ((u & 31) + 1) - ((const int*)(ws + WS_UINFO))[u]; }
        __syncthreads();
        { const int my = ucost[tid]; int rank = 0;
          for (int j = 0; j < 512; ++j) { const int c = ucost[j]; rank += (c > my || (c == my && j < tid)) ? 1 : 0; }
          uord[rank] = tid; }
        __syncthreads();
        for (int first = 1;; first = 0) {
            int p;
            if (first) p = bx;
            else {
                if (threadIdx.x == 0) slot[0] = G + (int)__hip_atomic_fetch_add((unsigned*)(ws + WS_UNITCTR), 1u, __ATOMIC_RELAXED, __HIP_MEMORY_SCOPE_AGENT);
                __syncthreads();
                p = __builtin_amdgcn_readfirstlane(slot[0]);
                __syncthreads();
            }
            if (p >= 512) break;
            const int u = __builtin_amdgcn_readfirstlane(uord[p]), bh = u >> 5, qb = u & 31, ts = __builtin_amdgcn_readfirstlane(4 * (qb + 1) - ucost[u]);
            const f32x4* gsrc = (const f32x4*)(GF + (size_t)bh * T);
            int t2 = threadIdx.x; asm volatile("" : "+v"(t2));
            for (int i = t2 + 16 * ts; i < (qb + 1) * 64; i += NWAVES * 64) ((LAS f32x4*)fk)[i] = gsrc[i];
            __syncthreads();
            attn_body::attn_unit<20>(bh >> 3, bh & 7, qb, (const attn_body::bf16*)QB, (const attn_body::bf16*)KB, (const attn_body::bf16*)VB, (attn_body::bf16*)(YAB + CW), (char*)lds, fk + 64 * ts, ts);
        }
        { int t3 = threadIdx.x; asm volatile("" : "+v"(t3)); const int lane = t3 & 63;
          const float* cw = args.in[I_CONVA];
          for (int first = 1;; first = 0) {
            int q;
            if (first) q = bx;
            else {
                if (t3 == 0) slot[0] = G + (int)__hip_atomic_fetch_add((unsigned*)(ws + WS_UNITCTR + 128), 1u, __ATOMIC_RELAXED, __HIP_MEMORY_SCOPE_AGENT);
                __syncthreads();
                q = __builtin_amdgcn_readfirstlane(slot[0]);
                __syncthreads();
            }
            if (q >= 344) break;
            if (q >= 256) {
                float s0[16], s1[16];
#pragma unroll
                for (int i = 0; i < 16; ++i) { const int k = 16 * lane + i; const float bb = bada[3 * D + k]; s0[i] = modacc[3 * D + k] + bb; s1[i] = modacc[NMOD + 3 * D + k] + bb; }
                for (int r = 0; r < 8; ++r) { const int n = 64 * (q - 256) + 8 * wave + r;
                    const v4u wa = *(const v4u*)(Wup_t + (size_t)n * D + 16 * lane), wb = *(const v4u*)(Wup_t + (size_t)n * D + 16 * lane + 8);
                    float a0 = 0.f, a1 = 0.f;
#pragma unroll
                    for (int i = 0; i < 4; ++i) { const float w0 = blo(wa[i]), w1 = bhi(wa[i]), w2 = blo(wb[i]), w3 = bhi(wb[i]);
                        a0 += w0 * s0[2 * i] + w1 * s0[2 * i + 1] + w2 * s0[8 + 2 * i] + w3 * s0[8 + 2 * i + 1];
                        a1 += w0 * s1[2 * i] + w1 * s1[2 * i + 1] + w2 * s1[8 + 2 * i] + w3 * s1[8 + 2 * i + 1]; }
                    a0 = wave_sum(a0); a1 = wave_sum(a1);
                    if (lane == 0) { cvec[n] = a0; cvec[NUP + n] = a1; } }
                continue;
            }
            const int m0 = 64 * q + 8 * wave;
            {
            const int t0 = m0 % T, col = lane * 8;
            float w0[8], w1[8], w2[8], p2[8], p1[8];
#pragma unroll
            for (int i = 0; i < 8; ++i) { w0[i] = cw[col + i]; w1[i] = cw[CW + col + i]; w2[i] = cw[2 * CW + col + i]; p2[i] = 0.f; p1[i] = 0.f; }
            if (t0 != 0) {
                const v4u a2 = *(const v4u*)(CC + (size_t)(m0 - 2) * CW + col), b2 = *(const v4u*)(CV + (size_t)(m0 - 2) * CW + col);
                const v4u a1 = *(const v4u*)(CC + (size_t)(m0 - 1) * CW + col), b1 = *(const v4u*)(CV + (size_t)(m0 - 1) * CW + col);
#pragma unroll
                for (int i = 0; i < 4; ++i) { p2[2 * i] = blo(a2[i]) * blo(b2[i]); p2[2 * i + 1] = bhi(a2[i]) * bhi(b2[i]); p1[2 * i] = blo(a1[i]) * blo(b1[i]); p1[2 * i + 1] = bhi(a1[i]) * bhi(b1[i]); }
            }
#pragma unroll
            for (int r = 0; r < 8; ++r) { const size_t m = (size_t)(m0 + r);
                const v4u a = *(const v4u*)(CC + m * CW + col), b = *(const v4u*)(CV + m * CW + col), cbv = *(const v4u*)(CB + m * CW + col);
                float cur[8], y[8];
#pragma unroll
                for (int i = 0; i < 4; ++i) { cur[2 * i] = blo(a[i]) * blo(b[i]); cur[2 * i + 1] = bhi(a[i]) * bhi(b[i]); }
#pragma unroll
                for (int i = 0; i < 8; ++i) { const float cbf = (i & 1) ? bhi(cbv[i >> 1]) : blo(cbv[i >> 1]); y[i] = cbf * (w0[i] * p2[i] + w1[i] * p1[i] + w2[i] * cur[i]); p2[i] = p1[i]; p1[i] = cur[i]; }
                v4u o; o.x = pk2(y[0], y[1]); o.y = pk2(y[2], y[3]); o.z = pk2(y[4], y[5]); o.w = pk2(y[6], y[7]);
                *(v4u*)(YAB + m * D + col) = o; }
            }
          }
        }
    }
    SEAM(3);
    if (IN(4)) {
        pg8::Gemm g{YAB, Wab_t, M, D, D}; pg8::StaticOrder S; S.init(M, D, G, bx);
        pg8::EpiMerged E{GA, GB, MERGED};
        pg8::gemm_phase<pg8::EpiMerged, pg8::StaticOrder, true, true>(ldsp, g, S, E);
    }
    SEAM(4);
    if (IN(5)) {
        pg8::Gemm g{MERGED, Wout_t, M, D, D}; pg8::StaticOrder S; S.init(M, D, G, bx);
        pg8::EpiRes<true> E{x, out, modacc + 2 * D, bada + 2 * D, T, NMOD, XN, args.in[I_N2G], modacc + 4 * D, bada + 4 * D, ssq, X1B};
        pg8::gemm_phase<pg8::EpiRes<true>, pg8::StaticOrder, true, true>(ldsp, g, S, E);
    }
    SEAM(5);
    if (IN(7)) {
        pg8::Gemm g{XN, Wup_t, M, NUP, D}; pg8::HaloOrder S; S.init(BATCH, NUP, G, bx);
        pg8::EpiUpConv E{ACT, ssq, cvec, args.in[I_CONVF], (LAS float*)(ldsp + 131072), 1.0f / D, RMS_EPS, DFF, NUP, T};
        pg8::gemm_phase<pg8::EpiUpConv, pg8::HaloOrder, true, true>(ldsp, g, S, E);
    }
    SEAM(7);
    if (IN(11)) {
        pg8::Gemm g{ACT, Wdn_t, M, D, DFF}; pg8::StaticOrder S; S.init(M, D, G, bx);
        pg8::EpiRes<false> E{nullptr, out, modacc + 5 * D, bada + 5 * D, T, NMOD, nullptr, nullptr, nullptr, nullptr, nullptr, X1B};
        pg8::gemm_phase<pg8::EpiRes<false>, pg8::StaticOrder, true, true>(ldsp, g, S, E);
    }
#undef IN
#undef SEAM
}

constexpr int LDS_BYTES = 147456;
extern "C" void kernel_launch(void* const* d_in, const int* in_sizes, int n_in, void* d_out, int out_size, void* d_ws, size_t ws_size, hipStream_t stream) {
    static int grid = 0;
    if (grid == 0) {
        if (n_in != 17 || out_size != M * D || ws_size < WS_END) { fprintf(stderr, "kernel_launch: unexpected shapes (n_in %d out %d ws %zu)\n", n_in, out_size, ws_size); grid = -1; return; }
        int dev = 0, cus = 0, per_cu = 0;
        (void)hipGetDevice(&dev); (void)hipDeviceGetAttribute(&cus, hipDeviceAttributeMultiprocessorCount, dev);
        (void)hipFuncSetAttribute((const void*)fwd_kernel, hipFuncAttributeMaxDynamicSharedMemorySize, LDS_BYTES);
        (void)hipOccupancyMaxActiveBlocksPerMultiprocessor(&per_cu, (const void*)fwd_kernel, NWAVES * 64, LDS_BYTES);
        if (per_cu < 1) per_cu = 1;
        (void)hipGetLastError();
        grid = cus * per_cu;
    }
    if (grid < 0) return;
    (void)hipMemsetAsync((char*)d_ws + WS_CTL, 0, CTL_ZERO_BYTES, stream);
    Args a{};
    for (int i = 0; i < 17; ++i) a.in[i] = (const float*)d_in[i];
    a.out = (float*)d_out; a.ws = (unsigned char*)d_ws;
#if MK_COOP
    a.ph_lo = 0; a.ph_hi = N_PHASES;
    void* kargs[] = {&a};
    hipError_t e = hipLaunchCooperativeKernel((const void*)fwd_kernel, dim3(grid), dim3(NWAVES * 64), kargs, LDS_BYTES, stream);
    if (e != hipSuccess) fprintf(stderr, "cooperative launch failed: %s (grid %d)\n", hipGetErrorString(e), grid);
#else
    for (int p = 0; p < N_PHASES; ++p) { a.ph_lo = p; a.ph_hi = p + 1; hipLaunchKernelGGL(fwd_kernel, dim3(grid), dim3(NWAVES * 64), LDS_BYTES, stream, a); }
#endif
}
```
